# Optimizing an MI355X kernel written in HIP

```python
import jax, jax.numpy as jnp
from jax import lax
import numpy as np

D_MODEL = 1024
BATCH = 2
SEQ = 8192
DEPTH = 1

PLE_DIM = 256
D_FF = 2816
HG_HEADS = 8
HG_DK = 128
HG_DV = 128
HG_WIDTH = HG_HEADS * HG_DK
HG_VWIDTH = HG_HEADS * HG_DV
CHUNK = 64
POOL_WINDOWS = (2, 4, 8, 16)
POOL_GROUPS = 4
POOL_CH = 128
POOL_WIDTH = POOL_GROUPS * POOL_CH
IN_SIZES = (HG_WIDTH, HG_WIDTH, HG_VWIDTH, HG_VWIDTH, POOL_WIDTH, D_MODEL, D_MODEL)
IN_COLS = HG_WIDTH * 2 + HG_VWIDTH * 2 + POOL_WIDTH + 2 * D_MODEL
EPS = 1e-6

kernel_name = "hybrid_hgrn2_pool_macaron_block"


def _rmsnorm(x, g):
    xf = x.astype(jnp.float32)
    y = xf * lax.rsqrt(jnp.mean(xf * xf, axis=-1, keepdims=True) + EPS)
    return (y * g.astype(jnp.float32)).astype(x.dtype)


def _swiglu(h, w1, w3, w2):
    return (jax.nn.silu(h @ w1) * (h @ w3)) @ w2


def _hgrn2_chunked(q, k, v, log_f):
    B, S, H, DK = q.shape
    DV = v.shape[-1]
    n_chunks = S // CHUNK

    def to_chunks(t):
        return t.reshape(B, n_chunks, CHUNK, H, t.shape[-1]).transpose(1, 0, 3, 2, 4)

    qc, kc, vc, gc = to_chunks(q), to_chunks(k), to_chunks(v), to_chunks(log_f)
    causal = jnp.tril(jnp.ones((CHUNK, CHUNK), dtype=bool))[:, :, None]

    def step(state, inp):
        qb, kb, vb, gb = inp
        G = jnp.cumsum(gb, axis=2)
        diff = G[:, :, :, None, :] - G[:, :, None, :, :]
        decay = jnp.exp(jnp.where(causal, diff, -jnp.inf))
        scores = jnp.einsum('bhtk,bhsk,bhtsk->bhts', qb, kb, decay)
        o_intra = jnp.einsum('bhts,bhsv->bhtv', scores, vb)
        o_inter = jnp.einsum('bhtk,bhkv->bhtv', qb * jnp.exp(G), state)
        G_last = G[:, :, -1:, :]
        k_dec = kb * jnp.exp(G_last - G)
        new_state = (jnp.exp(G_last[:, :, 0, :])[..., None] * state
                     + jnp.einsum('bhsk,bhsv->bhkv', k_dec, vb))
        return new_state, o_intra + o_inter

    state0 = jnp.zeros((B, H, DK, DV), jnp.float32)
    _, oc = lax.scan(step, state0, (qc, kc, vc, gc))
    return oc.transpose(1, 0, 3, 2, 4).reshape(B, S, H, DV)


def _causal_multiscale_pool(u):
    B, S, G, C = u.shape
    uf = u.astype(jnp.float32)
    cs = jnp.concatenate([jnp.zeros((B, 1, G, C), jnp.float32), jnp.cumsum(uf, axis=1)], axis=1)
    pos = jnp.arange(1, S + 1, dtype=jnp.float32)
    outs = []
    for g, w in enumerate(POOL_WINDOWS):
        csg = cs[:, :, g]
        upper = csg[:, 1:]
        lower = jnp.concatenate([jnp.zeros((B, w - 1, C), jnp.float32), csg[:, :S - w + 1]], axis=1)
        count = jnp.minimum(pos, float(w))[None, :, None]
        outs.append((upper - lower) / count - uf[:, :, g])
    return jnp.stack(outs, axis=2).astype(u.dtype)


def _normal(key, shape, fan_in):
    return jax.random.normal(key, shape, jnp.float32) * (fan_in ** -0.5)


def _gain(key, shape):
    return 1.0 + 0.02 * jax.random.normal(key, shape, jnp.float32)


def setup_inputs(seed: int = 0) -> dict:
    key = jax.random.key(seed)
    ks = jax.random.split(key, 26)
    L = DEPTH
    return {
        "x": jax.random.normal(ks[0], (BATCH, SEQ, D_MODEL), jnp.float32),
        "p": jax.random.normal(ks[1], (DEPTH, BATCH, SEQ, PLE_DIM), jnp.float32),
        "ffn1_norm": _gain(ks[2], (L, D_MODEL)),
        "ffn1_w1": _normal(ks[3], (L, D_MODEL, D_FF), D_MODEL),
        "ffn1_w3": _normal(ks[4], (L, D_MODEL, D_FF), D_MODEL),
        "ffn1_w2": _normal(ks[5], (L, D_FF, D_MODEL), D_FF),
        "mix_norm": _gain(ks[6], (L, D_MODEL)),
        "w_in": _normal(ks[7], (L, D_MODEL, IN_COLS), D_MODEL),
        "hgrn_lb": 0.1 * jax.random.normal(ks[8], (L + 1, HG_WIDTH), jnp.float32),
        "hgrn_onorm": _gain(ks[9], (L, HG_VWIDTH)),
        "w_branch_a": _normal(ks[10], (L, HG_VWIDTH, D_MODEL), HG_VWIDTH),
        "pool_w": _normal(ks[11], (L, POOL_GROUPS, POOL_CH, POOL_CH), POOL_CH),
        "pool_scale": _gain(ks[12], (L, POOL_WIDTH)),
        "w_branch_b": _normal(ks[13], (L, POOL_WIDTH, D_MODEL), POOL_WIDTH),
        "w_out": _normal(ks[14], (L, D_MODEL, D_MODEL), D_MODEL),
        "ffn2_norm": _gain(ks[15], (L, D_MODEL)),
        "ffn2_w1": _normal(ks[16], (L, D_MODEL, D_FF), D_MODEL),
        "ffn2_w3": _normal(ks[17], (L, D_MODEL, D_FF), D_MODEL),
        "ffn2_w2": _normal(ks[18], (L, D_FF, D_MODEL), D_FF),
        "ple_norm": _gain(ks[19], (L, D_MODEL)),
        "ple_w_gate": _normal(ks[20], (L, D_MODEL, D_MODEL), D_MODEL),
        "ple_w_proj": _normal(ks[21], (L, PLE_DIM, D_MODEL), PLE_DIM),
        "ple_post_norm": _gain(ks[22], (L, D_MODEL)),
        "final_norm": _gain(ks[23], (D_MODEL,)),
    }


def reference(x, p, ffn1_norm, ffn1_w1, ffn1_w3, ffn1_w2, mix_norm, w_in, hgrn_lb, hgrn_onorm,
              w_branch_a, pool_w, pool_scale, w_branch_b, w_out, ffn2_norm, ffn2_w1, ffn2_w3,
              ffn2_w2, ple_norm, ple_w_gate, ple_w_proj, ple_post_norm, final_norm):
    B, S, _ = x.shape
    split_points = [int(v) for v in np.cumsum(IN_SIZES)[:-1]]
    lb_all = jnp.cumsum(jax.nn.softmax(hgrn_lb.astype(jnp.float32), axis=0), axis=0)

    for i in range(DEPTH):
        h = _rmsnorm(x, ffn1_norm[i])
        x = x + 0.5 * _swiglu(h, ffn1_w1[i], ffn1_w3[i], ffn1_w2[i])

        h = _rmsnorm(x, mix_norm[i])
        proj = h @ w_in[i]
        q_r, f_r, i_r, og_r, pool_r, ga_r, gb_r = jnp.split(proj, split_points, axis=-1)

        lb = lb_all[i]
        f = lb + (1.0 - lb) * jax.nn.sigmoid(f_r.astype(jnp.float32))
        log_f = jnp.log(f).reshape(B, S, HG_HEADS, HG_DK)
        k = (1.0 - f).reshape(B, S, HG_HEADS, HG_DK)
        q = jax.nn.silu(q_r.astype(jnp.float32)).reshape(B, S, HG_HEADS, HG_DK)
        v = i_r.astype(jnp.float32).reshape(B, S, HG_HEADS, HG_DV)
        o = _hgrn2_chunked(q, k, v, log_f).astype(x.dtype)
        o = _rmsnorm(o, hgrn_onorm[i].reshape(HG_HEADS, HG_DV)) * jax.nn.silu(og_r.reshape(B, S, HG_HEADS, HG_DV))
        y_a = o.reshape(B, S, HG_VWIDTH) @ w_branch_a[i]

        u = pool_r.reshape(B, S, POOL_GROUPS, POOL_CH)
        pooled = _causal_multiscale_pool(u)
        mixed = jnp.einsum('bsgc,gcd->bsgd', pooled, pool_w[i]).reshape(B, S, POOL_WIDTH) * pool_scale[i]
        y_b = mixed @ w_branch_b[i]

        y = jax.nn.sigmoid(ga_r) * y_a + jax.nn.sigmoid(gb_r) * y_b
        x = x + y @ w_out[i]

        h = _rmsnorm(x, ffn2_norm[i])
        x = x + 0.5 * _swiglu(h, ffn2_w1[i], ffn2_w3[i], ffn2_w2[i])

        gate = jax.nn.sigmoid(_rmsnorm(x, ple_norm[i]) @ ple_w_gate[i])
        e = _rmsnorm(p[i] @ ple_w_proj[i], ple_post_norm[i])
        x = x + gate * e

    return _rmsnorm(x, final_norm)
```

```cpp
#include <hip/hip_runtime.h>
#include <hip/hip_cooperative_groups.h>
#include <cstdio>
#include <cstdint>
namespace cg = cooperative_groups;
namespace pg8 {
#define PG8_LAS __attribute__((address_space(3)))
typedef unsigned short bf16_t;
typedef short bf16x8 __attribute__((ext_vector_type(8)));
typedef float f32x4 __attribute__((ext_vector_type(4)));
typedef unsigned u32x4 __attribute__((ext_vector_type(4)));
constexpr int BM = 256, BK = 64, HALF = 128, HTB = HALF * BK * 2  , STAGE_BYTES = 8 * HTB, NXCD = 8, WGM = 8;

__host__ __device__ __forceinline__ int lds_byte(int r, int c) { const int st = (r >> 4) * 2 + (c >> 5), rr = r & 15, cc = c & 31, ob = rr * 64 + cc * 2; return st * 1024 + (ob ^ (((ob >> 9) & 1) << 5)); }
__host__ __device__ __forceinline__ void stage_rc(int b, int& R, int& C) { const int st = b / 1024, sb = b % 1024, swz = sb ^ (((sb >> 9) & 1) << 5); R = (st >> 1) * 16 + swz / 64; C = (st & 1) * 32 + (swz % 64) / 2; }
__host__ __device__ __forceinline__ int perm32(int rho) { const int n = rho >> 4, i = rho & 15; return 8 * (i >> 2) + 4 * n + (i & 3); }

struct Unit { int pm, pn; };
struct Gemm { const bf16_t* A; const bf16_t* Bt; int M, N, K; };

struct StaticOrder {
    int nM, nN, nwg, G, c;
    __host__ __device__ void init(int M, int N, int G_, int c_) { nM = M / BM; nN = N / BM; nwg = nM * nN; G = G_; c = c_; }
    __host__ __device__ bool next(int i, Unit& u) const {
        const long L = (long)i * G + c; if (L >= nwg) return false;
        int wgid = (int)L; { const int q = nwg / NXCD, r = nwg % NXCD, xcd = wgid % NXCD, off = wgid / NXCD; wgid = (xcd < r ? xcd * (q + 1) : r * (q + 1) + (xcd - r) * q) + off; }
        const int nig = WGM * nN, gid = wgid / nig, fm = gid * WGM, gsz = (nM - fm) < WGM ? (nM - fm) : WGM;
        u.pm = fm + ((wgid % nig) % gsz); u.pn = (wgid % nig) / gsz; return true;
    }
    __device__ __forceinline__ void a_ready(const Unit&) const {}
    __device__ __forceinline__ void done(const Unit&) const {}
};

typedef __bf16 bf16v2_t __attribute__((ext_vector_type(2)));
__device__ __forceinline__ unsigned cvt_pk_bf16(float lo, float hi) { bf16v2_t v; v[0] = (__bf16)lo; v[1] = (__bf16)hi; return __builtin_bit_cast(unsigned, v); }
typedef float f32x2 __attribute__((ext_vector_type(2)));
template <class Epi, class Sched, bool ALIGN_EPI = false, bool SP2 = false>
__device__ __forceinline__ void gemm_phase(PG8_LAS unsigned char* lds, const Gemm g, const Sched& S, const Epi& E) {
    const int tid = threadIdx.x, wid = __builtin_amdgcn_readfirstlane(tid >> 6), lane = tid & 63, wr = wid >> 2, wc = wid & 3, fr = lane & 15, fq = lane >> 4;
    const int K = g.K, nt = K / BK;
    unsigned voffA[2], voffB[2];
#pragma unroll
    for (int i = 0; i < 2; ++i) { int R, C; stage_rc(tid * 16 + i * 8192, R, C); const int Rb = Epi::PERM ? ((R & ~31) + perm32(R & 31)) : R;
        voffA[i] = (unsigned)(R * K + C) * 2u; voffB[i] = (unsigned)(Rb * K + C) * 2u; }
    const size_t kstep = (size_t)(BK * 2);
    const size_t hstep = (size_t)HALF * K * 2;
    const size_t tstep = 2 * hstep;
    const unsigned ldsw = (unsigned)wid * 1024u;
    const int aoff = lds_byte(wr * 64 + fr, fq * 8), boff = lds_byte(wc * 32 + fr, fq * 8);
#define PG8_SA(b, h) (((b) * 2 + (h)) * HTB)
#define PG8_SB(b, h) ((4 + (b) * 2 + (h)) * HTB)
#define PG8_STAGE(bufoff, gbase, voff) do { _Pragma("unroll") for (int _i = 0; _i < 2; ++_i) \
        __builtin_amdgcn_global_load_lds((const unsigned*)((const char*)(gbase) + (voff)[_i]), (PG8_LAS unsigned*)(lds + (bufoff) + ldsw + _i * 8192), 16, 0, 0); } while (0)
#define PG8_LDA(dst, b, h) do { _Pragma("unroll") for (int m = 0; m < 4; ++m) _Pragma("unroll") for (int k = 0; k < 2; ++k) dst[m][k] = *(const PG8_LAS bf16x8*)(lds + PG8_SA(b, h) + aoff + m * 2048 + k * 1024); } while (0)
#define PG8_LDB(dst, b, h) do { _Pragma("unroll") for (int n = 0; n < 2; ++n) _Pragma("unroll") for (int k = 0; k < 2; ++k) dst[n][k] = *(const PG8_LAS bf16x8*)(lds + PG8_SB(b, h) + boff + n * 2048 + k * 1024); } while (0)
#define PG8_MMA(ai, bj, At, Bt) do { __builtin_amdgcn_s_setprio(1); _Pragma("unroll") for (int m = 0; m < 4; ++m) _Pragma("unroll") for (int n = 0; n < 2; ++n) _Pragma("unroll") for (int k = 0; k < 2; ++k) \
        acc[ai][bj][m][n] = __builtin_amdgcn_mfma_f32_16x16x32_bf16(Bt[n][k], At[m][k], acc[ai][bj][m][n], 0, 0, 0); __builtin_amdgcn_s_setprio(0); } while (0)
#define PG8_WAIT_V(n) asm volatile("s_waitcnt vmcnt(" #n ")" ::: "memory")
#define PG8_WAIT_L(n) asm volatile("s_waitcnt lgkmcnt(" #n ")" ::: "memory")
#define PG8_BAR __builtin_amdgcn_s_barrier()
#define PG8_SCHED __builtin_amdgcn_sched_barrier(0)
    Unit cur, nxt; int ui = 0;
    if (!S.next(0, cur)) return;
    f32x4 acc[2][2][4][2];
#pragma unroll
    for (int a = 0; a < 2; ++a)
#pragma unroll
        for (int b = 0; b < 2; ++b)
#pragma unroll
            for (int m = 0; m < 4; ++m)
#pragma unroll
                for (int n = 0; n < 2; ++n) acc[a][b][m][n] = (f32x4){0.f, 0.f, 0.f, 0.f};
    bf16x8 At[4][2], B0[2][2], B1[2][2];
    const char* cA = (const char*)g.A + (size_t)cur.pm * tstep; const char* cB = (const char*)g.Bt + (size_t)cur.pn * tstep;
    S.a_ready(cur);
    if constexpr (SP2) {
        PG8_STAGE(PG8_SB(0, 0), cB, voffB); PG8_STAGE(PG8_SB(0, 1), cB + hstep, voffB); PG8_STAGE(PG8_SA(0, 0), cA, voffA); PG8_STAGE(PG8_SA(0, 1), cA + hstep, voffA);
        if (wr == 1) PG8_BAR;
        PG8_WAIT_V(2); PG8_BAR;
        PG8_STAGE(PG8_SB(1, 0), cB + kstep, voffB); PG8_STAGE(PG8_SA(1, 0), cA + kstep, voffA); PG8_STAGE(PG8_SB(1, 1), cB + hstep + kstep, voffB);
        PG8_WAIT_V(6); PG8_BAR;
    } else {
        PG8_STAGE(PG8_SB(0, 0), cB, voffB); PG8_STAGE(PG8_SA(0, 0), cA, voffA); PG8_STAGE(PG8_SB(0, 1), cB + hstep, voffB); PG8_STAGE(PG8_SA(0, 1), cA + hstep, voffA);
        if (wr == 1) PG8_BAR;
        PG8_WAIT_V(4); PG8_BAR;
        PG8_STAGE(PG8_SB(1, 0), cB + kstep, voffB); PG8_STAGE(PG8_SA(1, 0), cA + kstep, voffA); PG8_STAGE(PG8_SB(1, 1), cB + hstep + kstep, voffB);
        PG8_WAIT_V(6); PG8_BAR;
    }
    for (;;) {
        const bool has_next = S.next(ui + 1, nxt);
        const char* nA = has_next ? (const char*)g.A + (size_t)nxt.pm * tstep : cA; const char* nB = has_next ? (const char*)g.Bt + (size_t)nxt.pn * tstep : cB;
        for (int t = 0; t < nt; t += 2) {
            const bool last = (t == nt - 2);
            const char* a1 = cA + (size_t)(t + 1) * kstep;
            const char* a2 = last ? nA : cA + (size_t)(t + 2) * kstep; const char* b2 = last ? nB : cB + (size_t)(t + 2) * kstep;
            const char* a3 = a2 + kstep; const char* b3 = b2 + kstep;
            if (last && has_next) S.a_ready(nxt);
            if constexpr (SP2) {
            PG8_LDB(B0, 0, 0); PG8_LDB(B1, 0, 1); PG8_SCHED; PG8_LDA(At, 0, 0); PG8_STAGE(PG8_SA(1, 1), a1 + hstep, voffA);
            PG8_WAIT_V(8); PG8_WAIT_L(0); PG8_BAR; PG8_MMA(0, 0, At, B0); PG8_MMA(0, 1, At, B1); PG8_BAR; PG8_SCHED;
            PG8_LDA(At, 0, 1); PG8_STAGE(PG8_SB(0, 0), b2, voffB); PG8_STAGE(PG8_SB(0, 1), b2 + hstep, voffB); PG8_STAGE(PG8_SA(0, 0), a2, voffA);
            PG8_WAIT_V(8); PG8_WAIT_L(0); PG8_BAR; PG8_MMA(1, 0, At, B0); PG8_MMA(1, 1, At, B1); PG8_BAR; PG8_SCHED;
            PG8_LDB(B0, 1, 0); PG8_LDB(B1, 1, 1); PG8_SCHED; PG8_LDA(At, 1, 0); PG8_STAGE(PG8_SA(0, 1), a2 + hstep, voffA);
            PG8_WAIT_V(8); PG8_WAIT_L(0); PG8_BAR; PG8_MMA(0, 0, At, B0); PG8_MMA(0, 1, At, B1); PG8_BAR; PG8_SCHED;
            PG8_LDA(At, 1, 1); PG8_STAGE(PG8_SB(1, 0), b3, voffB); PG8_STAGE(PG8_SB(1, 1), b3 + hstep, voffB); PG8_STAGE(PG8_SA(1, 0), a3, voffA);
            PG8_WAIT_V(8); PG8_WAIT_L(0); PG8_BAR; PG8_MMA(1, 0, At, B0); PG8_MMA(1, 1, At, B1); PG8_BAR; PG8_SCHED;
            } else {
            PG8_LDB(B0, 0, 0); PG8_SCHED; PG8_LDA(At, 0, 0); PG8_STAGE(PG8_SA(1, 1), a1 + hstep, voffA);
            PG8_WAIT_L(8); PG8_BAR; PG8_WAIT_L(0); PG8_MMA(0, 0, At, B0); PG8_BAR; PG8_SCHED;
            PG8_LDB(B1, 0, 1); PG8_STAGE(PG8_SB(0, 0), b2, voffB);
            PG8_BAR; PG8_WAIT_L(0); PG8_MMA(0, 1, At, B1); PG8_BAR;
            PG8_LDA(At, 0, 1); PG8_STAGE(PG8_SA(0, 0), a2, voffA);
            PG8_BAR; PG8_WAIT_L(0); PG8_MMA(1, 0, At, B0); PG8_BAR; PG8_SCHED;
            PG8_STAGE(PG8_SB(0, 1), b2 + hstep, voffB);
            PG8_WAIT_V(6); PG8_BAR; PG8_MMA(1, 1, At, B1); PG8_BAR;
            PG8_LDB(B0, 1, 0); PG8_SCHED; PG8_LDA(At, 1, 0); PG8_STAGE(PG8_SA(0, 1), a2 + hstep, voffA);
            PG8_WAIT_L(8); PG8_BAR; PG8_WAIT_L(0); PG8_MMA(0, 0, At, B0); PG8_BAR; PG8_SCHED;
            PG8_LDB(B1, 1, 1); PG8_STAGE(PG8_SB(1, 0), b3, voffB);
            PG8_BAR; PG8_WAIT_L(0); PG8_MMA(0, 1, At, B1); PG8_BAR;
            PG8_LDA(At, 1, 1); PG8_STAGE(PG8_SA(1, 0), a3, voffA);
            PG8_BAR; PG8_WAIT_L(0); PG8_MMA(1, 0, At, B0); PG8_BAR; PG8_SCHED;
            PG8_STAGE(PG8_SB(1, 1), b3 + hstep, voffB);
            PG8_WAIT_V(6); PG8_BAR; PG8_MMA(1, 1, At, B1); PG8_BAR;
            }
        }
        if constexpr (ALIGN_EPI) { if (wr == 0) PG8_BAR; }
        if constexpr (!Epi::AFTER_DRAIN) { E(acc, cur, wr, wc, fr, fq); S.done(cur); }
        if (!has_next) break;
#pragma unroll
        for (int a = 0; a < 2; ++a)
#pragma unroll
            for (int b = 0; b < 2; ++b)
#pragma unroll
                for (int m = 0; m < 4; ++m)
#pragma unroll
                    for (int n = 0; n < 2; ++n) acc[a][b][m][n] = (f32x4){0.f, 0.f, 0.f, 0.f};
        cur = nxt; cA = nA; cB = nB; ++ui;
        if constexpr (ALIGN_EPI) { if (wr == 1) PG8_BAR; }
    }
    PG8_WAIT_V(0);
    if constexpr (!ALIGN_EPI) { if (wr == 0) PG8_BAR; }
    PG8_BAR;
    if constexpr (Epi::AFTER_DRAIN) { E.fused(acc, cur, wr, wc, fr, fq, lds, wid, lane); S.done(cur); }
#undef PG8_SA
#undef PG8_SB
#undef PG8_STAGE
#undef PG8_LDA
#undef PG8_LDB
#undef PG8_MMA
#undef PG8_WAIT_V
#undef PG8_WAIT_L
#undef PG8_BAR
#undef PG8_SCHED
}
}

#ifndef MK_ONE_LAUNCH
#define MK_ONE_LAUNCH 1
#endif
using pg8::bf16_t; using pg8::bf16x8; using pg8::f32x4; using pg8::u32x4; using pg8::Unit; using pg8::cvt_pk_bf16;
typedef unsigned u32x2 __attribute__((ext_vector_type(2)));
#define LAS __attribute__((address_space(3)))
#define DI __device__ __forceinline__

constexpr int M = 16384, D = 1024, FF = 2816, NUP = 2 * FF, NIN = 6656, SEQ = 8192, PLE = 256, POOLW = 512;
constexpr float EPS = 1e-6f;
constexpr int NWAVES = 8, NTHR = 512;
constexpr size_t MiB = 1u << 20;
constexpr size_t WS_SS0 = 0, WS_SS1 = 1 * MiB, WS_SSE = 2 * MiB, WS_DVEC = 3 * MiB, WS_LB = 3 * MiB + 512 * 1024;
constexpr size_t WS_WUP = 4 * MiB, WS_WDN = 15 * MiB, WS_WIN = 21 * MiB, WS_WA = 34 * MiB, WS_WPB = 36 * MiB, WS_WOUT = 37 * MiB, WS_WG = 39 * MiB, WS_WPLE = 41 * MiB;
constexpr size_t WS_XB = 42 * MiB, WS_PB = 74 * MiB, WS_BIG = 82 * MiB;
constexpr size_t WS_Q = WS_BIG, WS_LF = WS_BIG + 32 * MiB, WS_V = WS_BIG + 64 * MiB, WS_OG = WS_BIG + 96 * MiB, WS_S = WS_BIG + 128 * MiB;
constexpr size_t WS_U = WS_S, WS_POOLED = WS_S + 16 * MiB, WS_YA = WS_OG, WS_H = WS_BIG, WS_ERAW = WS_S, WS_END = WS_BIG + 160 * MiB;
static_assert(WS_END <= 256 * MiB, "workspace map");
static_assert(WS_WUP + (size_t)NUP * D * 2 <= WS_WDN && WS_WDN + (size_t)D * FF * 2 <= WS_WIN && WS_WIN + (size_t)NIN * D * 2 <= WS_WA, "weights map");
static_assert(WS_H + (size_t)M * FF * 2 <= WS_S, "H overlay");
constexpr int LDS_BYTES = 147456;

DI float bf2f(unsigned short h) { return __uint_as_float((unsigned)h << 16); }
DI unsigned short f2bf(float f) { return (unsigned short)(cvt_pk_bf16(f, 0.f) & 0xffffu); }
DI float silu_f(float x) { return x * __builtin_amdgcn_rcpf(1.f + __expf(-x)); }
DI float sigmoid_f(float x) { return __builtin_amdgcn_rcpf(1.f + __expf(-x)); }
DI float row_rs(const float* SS, int row, int fq) {
    const f32x4 v = *(const f32x4*)(SS + (size_t)row * 16 + fq * 4); float s = (v[0] + v[1]) + (v[2] + v[3]);
    s += __shfl_xor(s, 16); s += __shfl_xor(s, 32); return rsqrtf(s * (1.0f / D) + EPS);
}
#define ROW_OF(u, ai, m) ((u).pm * 256 + (ai) * 128 + wr * 64 + (m) * 16 + fr)

struct EpiFFN { static constexpr bool PERM = true, AFTER_DRAIN = false; bf16_t* H; const float* SS;
    DI void operator()(const f32x4 (&acc)[2][2][4][2], const Unit& u, int wr, int wc, int fr, int fq) const {
        const int col = u.pn * 128 + wc * 32 + 8 * fq;
#pragma unroll
        for (int ai = 0; ai < 2; ++ai)
#pragma unroll
            for (int m = 0; m < 4; ++m) { const int row = ROW_OF(u, ai, m); const float rs = row_rs(SS, row, fq);
                const f32x4 a0 = acc[ai][0][m][0] * rs, a1 = acc[ai][0][m][1] * rs, b0 = acc[ai][1][m][0] * rs, b1 = acc[ai][1][m][1] * rs;
                u32x4 w; w.x = cvt_pk_bf16(silu_f(a0[0]) * b0[0], silu_f(a0[1]) * b0[1]); w.y = cvt_pk_bf16(silu_f(a0[2]) * b0[2], silu_f(a0[3]) * b0[3]);
                w.z = cvt_pk_bf16(silu_f(a1[0]) * b1[0], silu_f(a1[1]) * b1[1]); w.w = cvt_pk_bf16(silu_f(a1[2]) * b1[2], silu_f(a1[3]) * b1[3]);
                *(u32x4*)(H + (size_t)row * FF + col) = w; }
    } };
struct EpiResid { static constexpr bool PERM = false, AFTER_DRAIN = false; const float* resid; float* out; bf16_t* XB; float* SSo; float alpha;
    DI void operator()(const f32x4 (&acc)[2][2][4][2], const Unit& u, int wr, int wc, int fr, int fq) const {
#pragma unroll
        for (int ai = 0; ai < 2; ++ai)
#pragma unroll
            for (int m = 0; m < 4; ++m) { const int row = ROW_OF(u, ai, m); float ss = 0.f;
#pragma unroll
                for (int bj = 0; bj < 2; ++bj)
#pragma unroll
                    for (int n = 0; n < 2; ++n) { const size_t off = (size_t)row * D + u.pn * 256 + bj * 128 + wc * 32 + 16 * n + 4 * fq;
                        const f32x4 o = *(const f32x4*)(resid + off) + acc[ai][bj][m][n] * alpha; *(f32x4*)(out + off) = o;
                        u32x2 w; w.x = cvt_pk_bf16(o[0], o[1]); w.y = cvt_pk_bf16(o[2], o[3]); *(u32x2*)(XB + off) = w;
                        ss += (o[0] * o[0] + o[1] * o[1]) + (o[2] * o[2] + o[3] * o[3]); }
                ss += __shfl_xor(ss, 16); ss += __shfl_xor(ss, 32);
                if (fq == 0) SSo[(size_t)row * 16 + u.pn * 4 + wc] = ss; }
    } };
struct Seg { bf16_t* dst; int ldc; int tile0; int act; };
struct EpiProj { static constexpr bool PERM = true, AFTER_DRAIN = false; Seg seg[4]; int nseg; const float* SS; const float* lb;
    DI void operator()(const f32x4 (&acc)[2][2][4][2], const Unit& u, int wr, int wc, int fr, int fq) const {
        Seg s = seg[0];
#pragma unroll
        for (int i = 1; i < 4; ++i) if (i < nseg && u.pn >= seg[i].tile0) s = seg[i];
        const int col0 = (u.pn - s.tile0) * 256 + wc * 32 + 8 * fq;
        f32x4 l0[2], l1[2];
#pragma unroll
        for (int bj = 0; bj < 2; ++bj) { if (s.act == 3) { l0[bj] = *(const f32x4*)(lb + col0 + bj * 128); l1[bj] = *(const f32x4*)(lb + col0 + bj * 128 + 4); } else { l0[bj] = (f32x4){0.f, 0.f, 0.f, 0.f}; l1[bj] = l0[bj]; } }
#pragma unroll
        for (int ai = 0; ai < 2; ++ai)
#pragma unroll
            for (int m = 0; m < 4; ++m) { const int row = ROW_OF(u, ai, m); const float rs = row_rs(SS, row, fq);
#pragma unroll
                for (int bj = 0; bj < 2; ++bj) { f32x4 v0 = acc[ai][bj][m][0] * rs, v1 = acc[ai][bj][m][1] * rs;
                    if (s.act == 1) {
#pragma unroll
                        for (int i = 0; i < 4; ++i) { v0[i] = silu_f(v0[i]); v1[i] = silu_f(v1[i]); }
                    } else if (s.act == 2) {
#pragma unroll
                        for (int i = 0; i < 4; ++i) { v0[i] = sigmoid_f(v0[i]); v1[i] = sigmoid_f(v1[i]); }
                    } else if (s.act == 3) {
#pragma unroll
                        for (int i = 0; i < 4; ++i) { v0[i] = __logf(l0[bj][i] + (1.f - l0[bj][i]) * sigmoid_f(v0[i])); v1[i] = __logf(l1[bj][i] + (1.f - l1[bj][i]) * sigmoid_f(v1[i])); }
                    }
                    u32x4 w; w.x = cvt_pk_bf16(v0[0], v0[1]); w.y = cvt_pk_bf16(v0[2], v0[3]); w.z = cvt_pk_bf16(v1[0], v1[1]); w.w = cvt_pk_bf16(v1[2], v1[3]);
                    *(u32x4*)(s.dst + (size_t)row * s.ldc + col0 + bj * 128) = w; } }
    } };
struct EpiGate { static constexpr bool PERM = true, AFTER_DRAIN = false; const bf16_t* gate; const bf16_t* add; bf16_t* out;
    DI void operator()(const f32x4 (&acc)[2][2][4][2], const Unit& u, int wr, int wc, int fr, int fq) const {
#pragma unroll
        for (int ai = 0; ai < 2; ++ai)
#pragma unroll
            for (int m = 0; m < 4; ++m) { const int row = ROW_OF(u, ai, m);
#pragma unroll
                for (int bj = 0; bj < 2; ++bj) { const size_t off = (size_t)row * D + u.pn * 256 + bj * 128 + wc * 32 + 8 * fq;
                    const u32x4 g = *(const u32x4*)(gate + off); u32x4 a = (u32x4){0u, 0u, 0u, 0u}; if (add) a = *(const u32x4*)(add + off);
                    const f32x4 v0 = acc[ai][bj][m][0], v1 = acc[ai][bj][m][1]; u32x4 w;
                    w.x = cvt_pk_bf16(__uint_as_float(a.x << 16) + __uint_as_float(g.x << 16) * v0[0], __uint_as_float(a.x & 0xffff0000u) + __uint_as_float(g.x & 0xffff0000u) * v0[1]);
                    w.y = cvt_pk_bf16(__uint_as_float(a.y << 16) + __uint_as_float(g.y << 16) * v0[2], __uint_as_float(a.y & 0xffff0000u) + __uint_as_float(g.y & 0xffff0000u) * v0[3]);
                    w.z = cvt_pk_bf16(__uint_as_float(a.z << 16) + __uint_as_float(g.z << 16) * v1[0], __uint_as_float(a.z & 0xffff0000u) + __uint_as_float(g.z & 0xffff0000u) * v1[1]);
                    w.w = cvt_pk_bf16(__uint_as_float(a.w << 16) + __uint_as_float(g.w << 16) * v1[2], __uint_as_float(a.w & 0xffff0000u) + __uint_as_float(g.w & 0xffff0000u) * v1[3]);
                    *(u32x4*)(out + off) = w; } }
    } };
struct EpiEraw { static constexpr bool PERM = true, AFTER_DRAIN = false; bf16_t* E; float* SSo;
    DI void operator()(const f32x4 (&acc)[2][2][4][2], const Unit& u, int wr, int wc, int fr, int fq) const {
#pragma unroll
        for (int ai = 0; ai < 2; ++ai)
#pragma unroll
            for (int m = 0; m < 4; ++m) { const int row = ROW_OF(u, ai, m); float ss = 0.f;
#pragma unroll
                for (int bj = 0; bj < 2; ++bj) { const size_t off = (size_t)row * D + u.pn * 256 + bj * 128 + wc * 32 + 8 * fq; const f32x4 v0 = acc[ai][bj][m][0], v1 = acc[ai][bj][m][1];
                    u32x4 w; w.x = cvt_pk_bf16(v0[0], v0[1]); w.y = cvt_pk_bf16(v0[2], v0[3]); w.z = cvt_pk_bf16(v1[0], v1[1]); w.w = cvt_pk_bf16(v1[2], v1[3]); *(u32x4*)(E + off) = w;
                    ss += (v0[0] * v0[0] + v0[1] * v0[1]) + (v0[2] * v0[2] + v0[3] * v0[3]) + (v1[0] * v1[0] + v1[1] * v1[1]) + (v1[2] * v1[2] + v1[3] * v1[3]); }
                ss += __shfl_xor(ss, 16); ss += __shfl_xor(ss, 32);
                if (fq == 0) SSo[(size_t)row * 16 + u.pn * 4 + wc] = ss; }
    } };
struct EpiPle { static constexpr bool PERM = false, AFTER_DRAIN = false; float* x; const bf16_t* E; const float* SS; const float* SSe; const float* gpost; float* SSo;
    DI void operator()(const f32x4 (&acc)[2][2][4][2], const Unit& u, int wr, int wc, int fr, int fq) const {
#pragma unroll
        for (int ai = 0; ai < 2; ++ai)
#pragma unroll
            for (int m = 0; m < 4; ++m) { const int row = ROW_OF(u, ai, m); const float rs = row_rs(SS, row, fq), rse = row_rs(SSe, row, fq); float ss = 0.f;
#pragma unroll
                for (int bj = 0; bj < 2; ++bj)
#pragma unroll
                    for (int n = 0; n < 2; ++n) { const int col = u.pn * 256 + bj * 128 + wc * 32 + 16 * n + 4 * fq; const size_t off = (size_t)row * D + col;
                        const u32x2 e = *(const u32x2*)(E + off); const f32x4 gp = *(const f32x4*)(gpost + col); const f32x4 a = acc[ai][bj][m][n] * rs; f32x4 o = *(const f32x4*)(x + off);
                        o[0] += sigmoid_f(a[0]) * (__uint_as_float(e.x << 16) * rse * gp[0]); o[1] += sigmoid_f(a[1]) * (__uint_as_float(e.x & 0xffff0000u) * rse * gp[1]);
                        o[2] += sigmoid_f(a[2]) * (__uint_as_float(e.y << 16) * rse * gp[2]); o[3] += sigmoid_f(a[3]) * (__uint_as_float(e.y & 0xffff0000u) * rse * gp[3]);
                        *(f32x4*)(x + off) = o; ss += (o[0] * o[0] + o[1] * o[1]) + (o[2] * o[2] + o[3] * o[3]); }
                ss += __shfl_xor(ss, 16); ss += __shfl_xor(ss, 32);
                if (fq == 0) SSo[(size_t)row * 16 + u.pn * 4 + wc] = ss; }
    } };

DI float wave_sum(float v) {
#pragma unroll
    for (int o = 1; o < 64; o <<= 1) v += __shfl_xor(v, o);
    return v;
}
DI void transpose_item(const float* W, int ldw, int k0, int ns0, bf16_t* WT, int Kd, int drow0, const float* g, LAS float* scr, int lane) {
#pragma unroll 8
    for (int i = 0; i < 32; ++i) { const int kk = 2 * i + (lane >> 5); float w = W[(size_t)(k0 + kk) * ldw + ns0 + (lane & 31)]; if (g) w *= g[k0 + kk]; scr[kk * 33 + (lane & 31)] = w; }
    asm volatile("s_waitcnt lgkmcnt(0)" ::: "memory");
    const int c = lane & 7;
#pragma unroll
    for (int j = 0; j < 4; ++j) { const int n = (lane >> 3) + 8 * j; const LAS float* s = scr + (8 * c) * 33 + n;
        u32x4 o; o.x = cvt_pk_bf16(s[0 * 33], s[1 * 33]); o.y = cvt_pk_bf16(s[2 * 33], s[3 * 33]); o.z = cvt_pk_bf16(s[4 * 33], s[5 * 33]); o.w = cvt_pk_bf16(s[6 * 33], s[7 * 33]);
        *(u32x4*)(WT + (size_t)(drow0 + n) * Kd + k0 + 8 * c) = o; }
    asm volatile("s_waitcnt lgkmcnt(0)" ::: "memory");
}
DI void transpose_job(const float* W, int K, int N, bf16_t* WT, const float* g, LAS float* scr, int lane, int gw, int NGW, int& base) {
    const int nblk = N / 32, nit = (K / 64) * nblk;
    for (int it = ((gw - base) % NGW + NGW) % NGW; it < nit; it += NGW) { const int kb = it / nblk, nb = it % nblk; transpose_item(W, N, 64 * kb, 32 * nb, WT, K, 32 * nb, g, scr, lane); }
    base = (base + nit) % NGW;
}
DI void transpose_up_job(const float* W1, const float* W3, bf16_t* WT, const float* g, LAS float* scr, int lane, int gw, int NGW, int& base) {
    const int nblk = NUP / 32, nit = (D / 64) * nblk;
    for (int it = ((gw - base) % NGW + NGW) % NGW; it < nit; it += NGW) { const int kb = it / nblk, nb = it % nblk, j = nb >> 3, rr = nb & 7;
        transpose_item(rr < 4 ? W1 : W3, FF, 64 * kb, 128 * j + 32 * (rr & 3), WT, D, 32 * nb, g, scr, lane); }
    base = (base + nit) % NGW;
}

constexpr int HP = 272;
#define MFMA16(a, b, c) __builtin_amdgcn_mfma_f32_16x16x32_bf16((a), (b), (c), 0, 0, 0)
DI void hgrn_a_unit(LAS unsigned char* lds, int uidx, const bf16_t* LF, const bf16_t* V, bf16_t* S, float* dvec, int tid) {
    const int bh = uidx >> 6, nb = uidx & 63, b = bh >> 3, h = bh & 7;
    const size_t rowbase = (size_t)b * SEQ + nb * 128; const int colbase = h * 128;
    LAS unsigned char* KT = lds + 128 * HP; LAS unsigned char* VT = lds + 2 * 128 * HP; LAS float* segtot = (LAS float*)(lds + 3 * 128 * HP);
    const int c = tid & 127, seg = tid >> 7;
    const size_t g0 = (rowbase + seg * 32) * D + colbase + c;
    float lfv[32], G[32]; float run = 0.f;
#pragma unroll
    for (int i = 0; i < 32; ++i) { const float x = bf2f(LF[g0 + (size_t)i * D]); lfv[i] = x; run += x; G[i] = run; }
    segtot[seg * 128 + c] = run;
    __syncthreads();
    const float t0 = segtot[c], t1 = segtot[128 + c], t2 = segtot[256 + c], t3 = segtot[384 + c];
    const float off = seg == 0 ? 0.f : seg == 1 ? t0 : seg == 2 ? t0 + t1 : t0 + t1 + t2;
    const float glast = (t0 + t1) + (t2 + t3);
    if (seg == 0) dvec[(size_t)uidx * 128 + c] = __expf(glast);
#pragma unroll
    for (int j = 0; j < 4; ++j) { float kd[8], vv[8];
#pragma unroll
        for (int e = 0; e < 8; ++e) { const int i = 8 * j + e; kd[e] = (1.f - __expf(lfv[i])) * __expf(glast - (off + G[i])); vv[e] = bf2f(V[g0 + (size_t)i * D]); }
        u32x4 wk, wv; wk.x = cvt_pk_bf16(kd[0], kd[1]); wk.y = cvt_pk_bf16(kd[2], kd[3]); wk.z = cvt_pk_bf16(kd[4], kd[5]); wk.w = cvt_pk_bf16(kd[6], kd[7]);
        wv.x = cvt_pk_bf16(vv[0], vv[1]); wv.y = cvt_pk_bf16(vv[2], vv[3]); wv.z = cvt_pk_bf16(vv[4], vv[5]); wv.w = cvt_pk_bf16(vv[6], vv[7]);
        *(LAS u32x4*)(KT + c * HP + (seg * 32 + 8 * j) * 2) = wk; *(LAS u32x4*)(VT + c * HP + (seg * 32 + 8 * j) * 2) = wv; }
    __syncthreads();
    const int w = __builtin_amdgcn_readfirstlane(tid >> 6), lane = tid & 63, r = lane & 15, quad = lane >> 4;
    bf16x8 av[4];
#pragma unroll
    for (int ks = 0; ks < 4; ++ks) av[ks] = *(const LAS bf16x8*)(VT + (16 * w + r) * HP + (ks * 32 + quad * 8) * 2);
    bf16_t* So = S + (size_t)uidx * 16384;
#pragma unroll
    for (int kt = 0; kt < 8; ++kt) { f32x4 a = (f32x4){0.f, 0.f, 0.f, 0.f};
#pragma unroll
        for (int ks = 0; ks < 4; ++ks) { const bf16x8 bk = *(const LAS bf16x8*)(KT + (16 * kt + r) * HP + (ks * 32 + quad * 8) * 2); a = MFMA16(av[ks], bk, a); }
#pragma unroll
        for (int j = 0; j < 4; ++j) So[(16 * w + quad * 4 + j) * 128 + 16 * kt + r] = f2bf(a[j]); }
    __syncthreads();
}
DI void hgrn_scan(bf16_t* S, const float* dvec, int gtid, int nthr) {
    for (int item = gtid; item < 16 * 128 * 64; item += nthr) { const int bh = item >> 13, rem = item & 8191, v = rem >> 6, kp = rem & 63;
        unsigned* base = (unsigned*)(S + (size_t)bh * 64 * 16384 + v * 128 + kp * 2); const float* dv = dvec + (size_t)bh * 64 * 128 + kp * 2;
        float s0 = 0.f, s1 = 0.f;
#pragma unroll 8
        for (int n = 0; n < 64; ++n) { const unsigned d = base[(size_t)n * 8192]; const float d0 = dv[n * 128], d1 = dv[n * 128 + 1];
            base[(size_t)n * 8192] = cvt_pk_bf16(s0, s1); s0 = d0 * s0 + __uint_as_float(d << 16); s1 = d1 * s1 + __uint_as_float(d & 0xffff0000u); } }
}
DI void hgrn_c_unit(LAS unsigned char* lds, int uidx, const bf16_t* Q, const bf16_t* LF, const bf16_t* V, const bf16_t* OG, const bf16_t* S, const float* onorm, bf16_t* OUT, int tid) {
    const int bh = uidx >> 6, nb = uidx & 63, b = bh >> 3, h = bh & 7;
    const size_t rowbase = (size_t)b * SEQ + nb * 128; const int colbase = h * 128;
    LAS unsigned char* QT = lds; LAS unsigned char* KT = lds + 128 * HP; LAS unsigned char* VT = lds + 2 * 128 * HP; LAS float* segtot = (LAS float*)(lds + 3 * 128 * HP); LAS float* eg = segtot + 512;
    const int c = tid & 127, seg = tid >> 7;
    const size_t g0 = (rowbase + seg * 32) * D + colbase + c;
    float lfv[32], G[32]; float run = 0.f;
#pragma unroll
    for (int i = 0; i < 32; ++i) { const float x = bf2f(LF[g0 + (size_t)i * D]); lfv[i] = x; run += x; G[i] = run; }
    segtot[seg * 128 + c] = run;
    __syncthreads();
    const float t0 = segtot[c], t1 = segtot[128 + c], t2 = segtot[256 + c];
    const float off = seg == 0 ? 0.f : seg == 1 ? t0 : seg == 2 ? t0 + t1 : t0 + t1 + t2;
    const float gref = t0 + t1;
    if (seg == 0) eg[c] = __expf(gref);
#pragma unroll
    for (int i = 0; i < 32; ++i) { const float g = off + G[i]; const float q = bf2f(Q[g0 + (size_t)i * D]); const float kk = 1.f - __expf(lfv[i]);
        const int t = seg * 32 + i; *(LAS bf16_t*)(QT + t * HP + c * 2) = f2bf(q * __expf(g - gref)); *(LAS bf16_t*)(KT + t * HP + c * 2) = f2bf(kk * __expf(gref - g)); }
#pragma unroll
    for (int j = 0; j < 4; ++j) { float vv[8];
#pragma unroll
        for (int e = 0; e < 8; ++e) vv[e] = bf2f(V[g0 + (size_t)(8 * j + e) * D]);
        u32x4 wv; wv.x = cvt_pk_bf16(vv[0], vv[1]); wv.y = cvt_pk_bf16(vv[2], vv[3]); wv.z = cvt_pk_bf16(vv[4], vv[5]); wv.w = cvt_pk_bf16(vv[6], vv[7]);
        *(LAS u32x4*)(VT + c * HP + (seg * 32 + 8 * j) * 2) = wv; }
    __syncthreads();
    const int w = __builtin_amdgcn_readfirstlane(tid >> 6), lane = tid & 63, r = lane & 15, quad = lane >> 4;
    bf16x8 aq[4];
#pragma unroll
    for (int ks = 0; ks < 4; ++ks) aq[ks] = *(const LAS bf16x8*)(QT + (16 * w + r) * HP + (ks * 32 + quad * 8) * 2);
    for (int st = 0; st <= w; ++st) { f32x4 sc = (f32x4){0.f, 0.f, 0.f, 0.f};
#pragma unroll
        for (int ks = 0; ks < 4; ++ks) { const bf16x8 bk = *(const LAS bf16x8*)(KT + (16 * st + r) * HP + (ks * 32 + quad * 8) * 2); sc = MFMA16(aq[ks], bk, sc); }
#pragma unroll
        for (int j = 0; j < 4; ++j) { const int t = quad * 4 + j; const bool keep = (st < w) || (r <= t); *(LAS bf16_t*)(QT + (16 * w + t) * HP + (16 * st + r) * 2) = keep ? f2bf(sc[j]) : (bf16_t)0; } }
    if ((w & 1) == 0) {
#pragma unroll
        for (int j = 0; j < 4; ++j) *(LAS bf16_t*)(QT + (16 * w + quad * 4 + j) * HP + (16 * (w + 1) + r) * 2) = (bf16_t)0; }
    f32x4 o[8];
#pragma unroll
    for (int vt = 0; vt < 8; ++vt) o[vt] = (f32x4){0.f, 0.f, 0.f, 0.f};
    const int nks2 = (w >> 1) + 1;
    for (int ks2 = 0; ks2 < nks2; ++ks2) { const bf16x8 ap = *(const LAS bf16x8*)(QT + (16 * w + r) * HP + (ks2 * 32 + quad * 8) * 2);
#pragma unroll
        for (int vt = 0; vt < 8; ++vt) { const bf16x8 bv = *(const LAS bf16x8*)(VT + (16 * vt + r) * HP + (ks2 * 32 + quad * 8) * 2); o[vt] = MFMA16(ap, bv, o[vt]); } }
    const bf16_t* Su = S + (size_t)uidx * 16384;
#pragma unroll
    for (int ks = 0; ks < 4; ++ks) { const f32x4 e0 = *(const LAS f32x4*)(eg + ks * 32 + quad * 8), e1 = *(const LAS f32x4*)(eg + ks * 32 + quad * 8 + 4);
        const u32x4 qa = __builtin_bit_cast(u32x4, aq[ks]); u32x4 qs;
        qs.x = cvt_pk_bf16(__uint_as_float(qa.x << 16) * e0[0], __uint_as_float(qa.x & 0xffff0000u) * e0[1]); qs.y = cvt_pk_bf16(__uint_as_float(qa.y << 16) * e0[2], __uint_as_float(qa.y & 0xffff0000u) * e0[3]);
        qs.z = cvt_pk_bf16(__uint_as_float(qa.z << 16) * e1[0], __uint_as_float(qa.z & 0xffff0000u) * e1[1]); qs.w = cvt_pk_bf16(__uint_as_float(qa.w << 16) * e1[2], __uint_as_float(qa.w & 0xffff0000u) * e1[3]);
        const bf16x8 aqg = __builtin_bit_cast(bf16x8, qs);
#pragma unroll
        for (int vt = 0; vt < 8; ++vt) { const bf16x8 bs = *(const bf16x8*)(Su + (16 * vt + r) * 128 + ks * 32 + quad * 8); o[vt] = MFMA16(aqg, bs, o[vt]); } }
    float rstd[4];
#pragma unroll
    for (int j = 0; j < 4; ++j) { float ss = 0.f;
#pragma unroll
        for (int vt = 0; vt < 8; ++vt) ss += o[vt][j] * o[vt][j];
        ss += __shfl_xor(ss, 1); ss += __shfl_xor(ss, 2); ss += __shfl_xor(ss, 4); ss += __shfl_xor(ss, 8); rstd[j] = rsqrtf(ss * (1.0f / 128.0f) + EPS); }
#pragma unroll
    for (int vt = 0; vt < 8; ++vt) { const float gn = onorm[colbase + 16 * vt + r];
#pragma unroll
        for (int j = 0; j < 4; ++j) { const size_t off = (rowbase + 16 * w + quad * 4 + j) * D + colbase + 16 * vt + r; OUT[off] = f2bf(o[vt][j] * rstd[j] * gn * bf2f(OG[off])); } }
    __syncthreads();
}

struct Args { const float* in[24]; float* out; unsigned char* ws; int ph_lo, ph_hi; };
enum { P_PRO = 0, P_G1, P_G2, P_G3A, P_HA, P_SCAN, P_HC, P_G3B, P_POOL, P_G4A, P_G4B, P_G5, P_G6, P_G7, P_G8A, P_G8B, P_FIN, P_N };
enum { I_X = 0, I_P, I_F1N, I_F1W1, I_F1W3, I_F1W2, I_MIXN, I_WIN, I_LB, I_ONORM, I_WA, I_POOLW, I_POOLS, I_WB, I_WOUT, I_F2N, I_F2W1, I_F2W3, I_F2W2, I_PLEN, I_PLEG, I_PLEP, I_PLEPOST, I_FINN };

template <class Epi> DI void run_gemm(LAS unsigned char* lds, const bf16_t* A, const bf16_t* Bt, int N, int K, const Epi& E) {
    pg8::Gemm g{A, Bt, M, N, K}; pg8::StaticOrder S; S.init(M, N, (int)gridDim.x, (int)blockIdx.x);
    pg8::gemm_phase<Epi, pg8::StaticOrder, true, true>(lds, g, S, E);
}

__global__ void __launch_bounds__(NTHR, 2) fwd_kernel(Args args) {
    extern __shared__ __attribute__((aligned(16))) unsigned char lds_raw[];
    LAS unsigned char* lds = (LAS unsigned char*)lds_raw;
    const int tid = threadIdx.x, wave = __builtin_amdgcn_readfirstlane(tid >> 6);
#define FRESH_LANE() ({ int t_ = threadIdx.x; asm volatile("" : "+v"(t_)); t_ & 63; })
    const int G = gridDim.x, gw = blockIdx.x * NWAVES + wave, NGW = G * NWAVES, gtid = blockIdx.x * NTHR + tid, nthr = G * NTHR;
    unsigned char* ws = args.ws;
    float* SS0 = (float*)(ws + WS_SS0); float* SS1 = (float*)(ws + WS_SS1); float* SSE = (float*)(ws + WS_SSE); float* DVEC = (float*)(ws + WS_DVEC); float* LB = (float*)(ws + WS_LB);
    bf16_t* WUP = (bf16_t*)(ws + WS_WUP); bf16_t* WDN = (bf16_t*)(ws + WS_WDN); bf16_t* WIN = (bf16_t*)(ws + WS_WIN); bf16_t* WA = (bf16_t*)(ws + WS_WA); bf16_t* WPB = (bf16_t*)(ws + WS_WPB);
    bf16_t* WOUT = (bf16_t*)(ws + WS_WOUT); bf16_t* WG = (bf16_t*)(ws + WS_WG); bf16_t* WPLE = (bf16_t*)(ws + WS_WPLE);
    bf16_t* XB = (bf16_t*)(ws + WS_XB); bf16_t* PB = (bf16_t*)(ws + WS_PB);
    bf16_t* Qb = (bf16_t*)(ws + WS_Q); bf16_t* LFb = (bf16_t*)(ws + WS_LF); bf16_t* Vb = (bf16_t*)(ws + WS_V); bf16_t* OGb = (bf16_t*)(ws + WS_OG); bf16_t* Sb = (bf16_t*)(ws + WS_S);
    bf16_t* Ub = (bf16_t*)(ws + WS_U); bf16_t* POOLED = (bf16_t*)(ws + WS_POOLED); bf16_t* YA = (bf16_t*)(ws + WS_YA); bf16_t* Hb = (bf16_t*)(ws + WS_H); bf16_t* ERAW = (bf16_t*)(ws + WS_ERAW);
    float* X = args.out;
    cg::grid_group grid = cg::this_grid();

    const int lo = args.ph_lo, hi = args.ph_hi;
#define IN(k) (lo <= (k) && (k) < hi)
#define SEAM(k) do { if ((k) + 1 < hi) { asm volatile("s_waitcnt vmcnt(0) lgkmcnt(0)" ::: "memory"); __syncthreads(); grid.sync(); \
    __builtin_amdgcn_fence(__ATOMIC_ACQUIRE, "agent"); asm volatile("s_waitcnt vmcnt(0)" ::: "memory"); } } while (0)
        if (IN(P_PRO)) { const int lane = FRESH_LANE();
            LAS float* scr = (LAS float*)(lds + wave * 16384);
            int base = 0;
            transpose_up_job(args.in[I_F1W1], args.in[I_F1W3], WUP, args.in[I_F1N], scr, lane, gw, NGW, base);
            transpose_job(args.in[I_F1W2], FF, D, WDN, nullptr, scr, lane, gw, NGW, base);
            transpose_job(args.in[I_WIN], D, NIN, WIN, args.in[I_MIXN], scr, lane, gw, NGW, base);
            transpose_job(args.in[I_WA], D, D, WA, nullptr, scr, lane, gw, NGW, base);
            transpose_job(args.in[I_WOUT], D, D, WOUT, nullptr, scr, lane, gw, NGW, base);
            transpose_job(args.in[I_PLEG], D, D, WG, args.in[I_PLEN], scr, lane, gw, NGW, base);
            transpose_job(args.in[I_PLEP], PLE, D, WPLE, nullptr, scr, lane, gw, NGW, base);
            { const float* pw = args.in[I_POOLW]; const float* ps = args.in[I_POOLS]; const float* wb = args.in[I_WB];
              for (int it = gtid; it < POOLW * D; it += nthr) { const int gc = it >> 10, n = it & 1023, g = gc >> 7; float a = 0.f;
                  for (int d = 0; d < 128; ++d) a += pw[(size_t)gc * 128 + d] * ps[g * 128 + d] * wb[(size_t)(g * 128 + d) * D + n];
                  WPB[(size_t)n * POOLW + gc] = f2bf(a); } }
            { const float* hl = args.in[I_LB]; for (int k = gtid; k < D; k += nthr) LB[k] = 1.f / (1.f + __expf(hl[D + k] - hl[k])); }
            { const float* x = args.in[I_X];
              for (int m = gw; m < M; m += NGW) { const f32x4* xr = (const f32x4*)(x + (size_t)m * D) + lane; float s = 0.f; unsigned long long* o8 = (unsigned long long*)(XB + (size_t)m * D) + lane;
#pragma unroll
                  for (int j = 0; j < 4; ++j) { const f32x4 v = xr[64 * j]; s += (v[0] * v[0] + v[1] * v[1]) + (v[2] * v[2] + v[3] * v[3]); o8[64 * j] = (unsigned long long)cvt_pk_bf16(v[0], v[1]) | ((unsigned long long)cvt_pk_bf16(v[2], v[3]) << 32); }
                  s = wave_sum(s); if (lane < 16) SS0[(size_t)m * 16 + lane] = lane == 0 ? s : 0.f; } }
            { const f32x4* p4 = (const f32x4*)args.in[I_P]; u32x2* o = (u32x2*)PB;
              for (int i = gtid; i < M * PLE / 4; i += nthr) { const f32x4 v = p4[i]; u32x2 w; w.x = cvt_pk_bf16(v[0], v[1]); w.y = cvt_pk_bf16(v[2], v[3]); o[i] = w; } }
            SEAM(P_PRO); }
        if (IN(P_G1)) { EpiFFN E{Hb, SS0}; run_gemm(lds, XB, WUP, NUP, D, E); SEAM(P_G1); }
        if (IN(P_G2)) { EpiResid E{args.in[I_X], X, XB, SS1, 0.5f}; run_gemm(lds, Hb, WDN, D, FF, E); SEAM(P_G2); }
        if (IN(P_G3A)) { EpiProj E; E.SS = SS1; E.lb = LB;
            E.seg[0] = Seg{Qb, D, 0, 1}; E.seg[1] = Seg{LFb, D, 4, 3}; E.seg[2] = Seg{Vb, D, 8, 0}; E.seg[3] = Seg{OGb, D, 12, 1}; E.nseg = 4;
            run_gemm(lds, XB, WIN, 4096, D, E); SEAM(P_G3A); }
        if (IN(P_HA)) { for (int u = blockIdx.x; u < 1024; u += G) hgrn_a_unit(lds, u, LFb, Vb, Sb, DVEC, tid); SEAM(P_HA); }
        if (IN(P_SCAN)) { const int lane = FRESH_LANE();
            hgrn_scan(Sb, DVEC, gtid, nthr);
            LAS float* scr = (LAS float*)(lds + wave * 16384); int base = 0;
            transpose_up_job(args.in[I_F2W1], args.in[I_F2W3], WUP, args.in[I_F2N], scr, lane, gw, NGW, base);
            transpose_job(args.in[I_F2W2], FF, D, WDN, nullptr, scr, lane, gw, NGW, base);
            SEAM(P_SCAN); }
        if (IN(P_HC)) { for (int u = blockIdx.x; u < 1024; u += G) hgrn_c_unit(lds, u, Qb, LFb, Vb, OGb, Sb, args.in[I_ONORM], Qb, tid); SEAM(P_HC); }
        if (IN(P_G3B)) { EpiProj E; E.SS = SS1; E.lb = LB;
            E.seg[0] = Seg{Ub, POOLW, 0, 0}; E.seg[1] = Seg{LFb  , D, 2, 2}; E.seg[2] = Seg{Vb  , D, 6, 2}; E.seg[3] = E.seg[2]; E.nseg = 3;
            run_gemm(lds, XB, WIN + (size_t)4096 * D, 2560, D, E); SEAM(P_G3B); }
        if (IN(P_POOL)) {
            for (int it = gtid; it < M * 64; it += nthr) { const int row = it >> 6, c8 = it & 63, g = c8 >> 4, wdw = 2 << g, t = row & (SEQ - 1); const int cnt = (t + 1) < wdw ? (t + 1) : wdw;
                const bf16_t* up = Ub + (size_t)row * POOLW + c8 * 8; float s[8], u0[8];
#pragma unroll
                for (int e = 0; e < 8; ++e) s[e] = 0.f;
                for (int j = 0; j < cnt; ++j) { const u32x4 v = *(const u32x4*)(up - (size_t)j * POOLW); float f[8] = {__uint_as_float(v.x << 16), __uint_as_float(v.x & 0xffff0000u), __uint_as_float(v.y << 16), __uint_as_float(v.y & 0xffff0000u),
                        __uint_as_float(v.z << 16), __uint_as_float(v.z & 0xffff0000u), __uint_as_float(v.w << 16), __uint_as_float(v.w & 0xffff0000u)};
#pragma unroll
                    for (int e = 0; e < 8; ++e) { s[e] += f[e]; if (j == 0) u0[e] = f[e]; } }
                const float inv = 1.f / (float)cnt; u32x4 w;
                w.x = cvt_pk_bf16(s[0] * inv - u0[0], s[1] * inv - u0[1]); w.y = cvt_pk_bf16(s[2] * inv - u0[2], s[3] * inv - u0[3]); w.z = cvt_pk_bf16(s[4] * inv - u0[4], s[5] * inv - u0[5]); w.w = cvt_pk_bf16(s[6] * inv - u0[6], s[7] * inv - u0[7]);
                *(u32x4*)(POOLED + (size_t)row * POOLW + c8 * 8) = w; }
            SEAM(P_POOL); }
        if (IN(P_G4A)) { EpiGate E{LFb, nullptr, YA}; run_gemm(lds, Qb, WA, D, D, E); SEAM(P_G4A); }
        if (IN(P_G4B)) { EpiGate E{Vb, YA, YA}; run_gemm(lds, POOLED, WPB, D, POOLW, E); SEAM(P_G4B); }
        if (IN(P_G5)) { EpiResid E{X, X, XB, SS0, 1.0f}; run_gemm(lds, YA, WOUT, D, D, E); SEAM(P_G5); }
        if (IN(P_G6)) { EpiFFN E{Hb, SS0}; run_gemm(lds, XB, WUP, NUP, D, E); SEAM(P_G6); }
        if (IN(P_G7)) { EpiResid E{X, X, XB, SS1, 0.5f}; run_gemm(lds, Hb, WDN, D, FF, E); SEAM(P_G7); }
        if (IN(P_G8A)) { EpiEraw E{ERAW, SSE}; run_gemm(lds, PB, WPLE, D, PLE, E); SEAM(P_G8A); }
        if (IN(P_G8B)) { EpiPle E{X, ERAW, SS1, SSE, args.in[I_PLEPOST], SS0}; run_gemm(lds, XB, WG, D, D, E); SEAM(P_G8B); }
        if (IN(P_FIN)) { const int lane = FRESH_LANE();
            const float* gf = args.in[I_FINN];
            for (int m = gw; m < M; m += NGW) { float s = SS0[(size_t)m * 16 + (lane & 15)]; s += __shfl_xor(s, 1); s += __shfl_xor(s, 2); s += __shfl_xor(s, 4); s += __shfl_xor(s, 8);
                const float rs = rsqrtf(s * (1.0f / D) + EPS); f32x4* xr = (f32x4*)(X + (size_t)m * D) + lane; const f32x4* g4 = (const f32x4*)gf + lane;
#pragma unroll
                for (int j = 0; j < 4; ++j) { const f32x4 v = xr[64 * j]; xr[64 * j] = v * rs * g4[64 * j]; } }
        }
#undef IN
#undef SEAM
}

extern "C" void kernel_launch(void* const* d_in, const int* in_sizes, int n_in, void* d_out, int out_size, void* d_ws, size_t ws_size, hipStream_t stream) {
    static int grid = 0;
    if (grid == 0) {
        if (n_in != 24 || out_size != M * D || ws_size < WS_END) { fprintf(stderr, "kernel_launch: unexpected shapes (n_in %d out %d ws %zu)\n", n_in, out_size, ws_size); grid = -1; return; }
        int dev = 0, cus = 0, per_cu = 0;
        hipGetDevice(&dev); hipDeviceGetAttribute(&cus, hipDeviceAttributeMultiprocessorCount, dev);
        if (hipFuncSetAttribute((const void*)fwd_kernel, hipFuncAttributeMaxDynamicSharedMemorySize, LDS_BYTES) != hipSuccess) { fprintf(stderr, "kernel_launch: hipFuncSetAttribute failed\n"); grid = -1; return; }
        if (hipOccupancyMaxActiveBlocksPerMultiprocessor(&per_cu, (const void*)fwd_kernel, NTHR, LDS_BYTES) != hipSuccess || per_cu < 1) { fprintf(stderr, "kernel_launch: occupancy query failed (%d)\n", per_cu); (void)hipGetLastError(); per_cu = 1; }
        grid = cus * per_cu;
        fprintf(stderr, "kernel_launch: grid %d (cus %d x %d)\n", grid, cus, per_cu);
    }
    if (grid < 0) return;
    Args a{};
    for (int i = 0; i < 24; ++i) a.in[i] = (const float*)d_in[i];
    a.out = (float*)d_out; a.ws = (unsigned char*)d_ws;
#if MK_ONE_LAUNCH
    a.ph_lo = 0; a.ph_hi = P_N;
    void* kargs[] = {&a};
    hipError_t e = hipLaunchCooperativeKernel((const void*)fwd_kernel, dim3(grid), dim3(NTHR), kargs, LDS_BYTES, stream);
    if (e != hipSuccess) fprintf(stderr, "kernel_launch: cooperative launch failed: %s (grid %d)\n", hipGetErrorString(e), grid);
#else
    for (int ph = 0; ph < P_N; ++ph) { a.ph_lo = ph; a.ph_hi = ph + 1; hipLaunchKernelGGL(fwd_kernel, dim3(grid), dim3(NTHR), LDS_BYTES, stream, a); }
#endif
}
```

```cpp
#include <hip/hip_runtime.h>
#include <hip/hip_cooperative_groups.h>
#include <cstdio>
#include <cstdint>
namespace cg = cooperative_groups;
namespace pg8 {
#define PG8_LAS __attribute__((address_space(3)))
typedef unsigned short bf16_t;
typedef short bf16x8 __attribute__((ext_vector_type(8)));
typedef float f32x4 __attribute__((ext_vector_type(4)));
typedef unsigned u32x4 __attribute__((ext_vector_type(4)));
constexpr int BM = 256, BK = 64, HALF = 128, HTB = HALF * BK * 2  , STAGE_BYTES = 8 * HTB, NXCD = 8, WGM = 8;

__host__ __device__ __forceinline__ int lds_byte(int r, int c) { const int st = (r >> 4) * 2 + (c >> 5), rr = r & 15, cc = c & 31, ob = rr * 64 + cc * 2; return st * 1024 + (ob ^ (((ob >> 9) & 1) << 5)); }
__host__ __device__ __forceinline__ void stage_rc(int b, int& R, int& C) { const int st = b / 1024, sb = b % 1024, swz = sb ^ (((sb >> 9) & 1) << 5); R = (st >> 1) * 16 + swz / 64; C = (st & 1) * 32 + (swz % 64) / 2; }
__host__ __device__ __forceinline__ int perm32(int rho) { const int n = rho >> 4, i = rho & 15; return 8 * (i >> 2) + 4 * n + (i & 3); }

struct Unit { int pm, pn; };
struct Gemm { const bf16_t* A; const bf16_t* Bt; int M, N, K; };

struct StaticOrder {
    int nM, nN, nwg, G, c;
    __host__ __device__ void init(int M, int N, int G_, int c_) { nM = M / BM; nN = N / BM; nwg = nM * nN; G = G_; c = c_; }
    __host__ __device__ bool next(int i, Unit& u) const {
        const long L = (long)i * G + c; if (L >= nwg) return false;
        int wgid = (int)L; { const int q = nwg / NXCD, r = nwg % NXCD, xcd = wgid % NXCD, off = wgid / NXCD; wgid = (xcd < r ? xcd * (q + 1) : r * (q + 1) + (xcd - r) * q) + off; }
        const int nig = WGM * nN, gid = wgid / nig, fm = gid * WGM, gsz = (nM - fm) < WGM ? (nM - fm) : WGM;
        u.pm = fm + ((wgid % nig) % gsz); u.pn = (wgid % nig) / gsz; return true;
    }
    __device__ __forceinline__ void a_ready(const Unit&) const {}
    __device__ __forceinline__ void done(const Unit&) const {}
};

typedef __bf16 bf16v2_t __attribute__((ext_vector_type(2)));
__device__ __forceinline__ unsigned cvt_pk_bf16(float lo, float hi) { bf16v2_t v; v[0] = (__bf16)lo; v[1] = (__bf16)hi; return __builtin_bit_cast(unsigned, v); }
typedef float f32x2 __attribute__((ext_vector_type(2)));
template <class Epi, class Sched, bool ALIGN_EPI = false, bool SP2 = false>
__device__ __forceinline__ void gemm_phase(PG8_LAS unsigned char* lds, const Gemm g, const Sched& S, const Epi& E) {
    const int tid = threadIdx.x, wid = __builtin_amdgcn_readfirstlane(tid >> 6), lane = tid & 63, wr = wid >> 2, wc = wid & 3, fr = lane & 15, fq = lane >> 4;
    const int K = g.K, nt = K / BK;
    unsigned voffA[2], voffB[2];
#pragma unroll
    for (int i = 0; i < 2; ++i) { int R, C; stage_rc(tid * 16 + i * 8192, R, C); const int Rb = Epi::PERM ? ((R & ~31) + perm32(R & 31)) : R;
        voffA[i] = (unsigned)(R * K + C) * 2u; voffB[i] = (unsigned)(Rb * K + C) * 2u; }
    const size_t kstep = (size_t)(BK * 2);
    const size_t hstep = (size_t)HALF * K * 2;
    const size_t tstep = 2 * hstep;
    const unsigned ldsw = (unsigned)wid * 1024u;
    const int aoff = lds_byte(wr * 64 + fr, fq * 8), boff = lds_byte(wc * 32 + fr, fq * 8);
#define PG8_SA(b, h) (((b) * 2 + (h)) * HTB)
#define PG8_SB(b, h) ((4 + (b) * 2 + (h)) * HTB)
#define PG8_STAGE(bufoff, gbase, voff) do { _Pragma("unroll") for (int _i = 0; _i < 2; ++_i) \
        __builtin_amdgcn_global_load_lds((const unsigned*)((const char*)(gbase) + (voff)[_i]), (PG8_LAS unsigned*)(lds + (bufoff) + ldsw + _i * 8192), 16, 0, 0); } while (0)
#define PG8_LDA(dst, b, h) do { _Pragma("unroll") for (int m = 0; m < 4; ++m) _Pragma("unroll") for (int k = 0; k < 2; ++k) dst[m][k] = *(const PG8_LAS bf16x8*)(lds + PG8_SA(b, h) + aoff + m * 2048 + k * 1024); } while (0)
#define PG8_LDB(dst, b, h) do { _Pragma("unroll") for (int n = 0; n < 2; ++n) _Pragma("unroll") for (int k = 0; k < 2; ++k) dst[n][k] = *(const PG8_LAS bf16x8*)(lds + PG8_SB(b, h) + boff + n * 2048 + k * 1024); } while (0)
#define PG8_MMA(ai, bj, At, Bt) do { __builtin_amdgcn_s_setprio(1); _Pragma("unroll") for (int m = 0; m < 4; ++m) _Pragma("unroll") for (int n = 0; n < 2; ++n) _Pragma("unroll") for (int k = 0; k < 2; ++k) \
        acc[ai][bj][m][n] = __builtin_amdgcn_mfma_f32_16x16x32_bf16(Bt[n][k], At[m][k], acc[ai][bj][m][n], 0, 0, 0); __builtin_amdgcn_s_setprio(0); } while (0)
#define PG8_WAIT_V(n) asm volatile("s_waitcnt vmcnt(" #n ")" ::: "memory")
#define PG8_WAIT_L(n) asm volatile("s_waitcnt lgkmcnt(" #n ")" ::: "memory")
#define PG8_BAR __builtin_amdgcn_s_barrier()
#define PG8_SCHED __builtin_amdgcn_sched_barrier(0)
    Unit cur, nxt; int ui = 0;
    if (!S.next(0, cur)) return;
    f32x4 acc[2][2][4][2];
#pragma unroll
    for (int a = 0; a < 2; ++a)
#pragma unroll
        for (int b = 0; b < 2; ++b)
#pragma unroll
            for (int m = 0; m < 4; ++m)
#pragma unroll
                for (int n = 0; n < 2; ++n) acc[a][b][m][n] = (f32x4){0.f, 0.f, 0.f, 0.f};
    bf16x8 At[4][2], B0[2][2], B1[2][2];
    const char* cA = (const char*)g.A + (size_t)cur.pm * tstep; const char* cB = (const char*)g.Bt + (size_t)cur.pn * tstep;
    S.a_ready(cur);
    if constexpr (SP2) {
        PG8_STAGE(PG8_SB(0, 0), cB, voffB); PG8_STAGE(PG8_SB(0, 1), cB + hstep, voffB); PG8_STAGE(PG8_SA(0, 0), cA, voffA); PG8_STAGE(PG8_SA(0, 1), cA + hstep, voffA);
        if (wr == 1) PG8_BAR;
        PG8_WAIT_V(2); PG8_BAR;
        PG8_STAGE(PG8_SB(1, 0), cB + kstep, voffB); PG8_STAGE(PG8_SA(1, 0), cA + kstep, voffA); PG8_STAGE(PG8_SB(1, 1), cB + hstep + kstep, voffB);
        PG8_WAIT_V(6); PG8_BAR;
    } else {
        PG8_STAGE(PG8_SB(0, 0), cB, voffB); PG8_STAGE(PG8_SA(0, 0), cA, voffA); PG8_STAGE(PG8_SB(0, 1), cB + hstep, voffB); PG8_STAGE(PG8_SA(0, 1), cA + hstep, voffA);
        if (wr == 1) PG8_BAR;
        PG8_WAIT_V(4); PG8_BAR;
        PG8_STAGE(PG8_SB(1, 0), cB + kstep, voffB); PG8_STAGE(PG8_SA(1, 0), cA + kstep, voffA); PG8_STAGE(PG8_SB(1, 1), cB + hstep + kstep, voffB);
        PG8_WAIT_V(6); PG8_BAR;
    }
    for (;;) {
        const bool has_next = S.next(ui + 1, nxt);
        const char* nA = has_next ? (const char*)g.A + (size_t)nxt.pm * tstep : cA; const char* nB = has_next ? (const char*)g.Bt + (size_t)nxt.pn * tstep : cB;
        for (int t = 0; t < nt; t += 2) {
            const bool last = (t == nt - 2);
            const char* a1 = cA + (size_t)(t + 1) * kstep;
            const char* a2 = last ? nA : cA + (size_t)(t + 2) * kstep; const char* b2 = last ? nB : cB + (size_t)(t + 2) * kstep;
            const char* a3 = a2 + kstep; const char* b3 = b2 + kstep;
            if (last && has_next) S.a_ready(nxt);
            if constexpr (SP2) {
            PG8_LDB(B0, 0, 0); PG8_LDB(B1, 0, 1); PG8_SCHED; PG8_LDA(At, 0, 0); PG8_STAGE(PG8_SA(1, 1), a1 + hstep, voffA);
            PG8_WAIT_V(8); PG8_WAIT_L(0); PG8_BAR; PG8_MMA(0, 0, At, B0); PG8_MMA(0, 1, At, B1); PG8_BAR; PG8_SCHED;
            PG8_LDA(At, 0, 1); PG8_STAGE(PG8_SB(0, 0), b2, voffB); PG8_STAGE(PG8_SB(0, 1), b2 + hstep, voffB); PG8_STAGE(PG8_SA(0, 0), a2, voffA);
            PG8_WAIT_V(8); PG8_WAIT_L(0); PG8_BAR; PG8_MMA(1, 0, At, B0); PG8_MMA(1, 1, At, B1); PG8_BAR; PG8_SCHED;
            PG8_LDB(B0, 1, 0); PG8_LDB(B1, 1, 1); PG8_SCHED; PG8_LDA(At, 1, 0); PG8_STAGE(PG8_SA(0, 1), a2 + hstep, voffA);
            PG8_WAIT_V(8); PG8_WAIT_L(0); PG8_BAR; PG8_MMA(0, 0, At, B0); PG8_MMA(0, 1, At, B1); PG8_BAR; PG8_SCHED;
            PG8_LDA(At, 1, 1); PG8_STAGE(PG8_SB(1, 0), b3, voffB); PG8_STAGE(PG8_SB(1, 1), b3 + hstep, voffB); PG8_STAGE(PG8_SA(1, 0), a3, voffA);
            PG8_WAIT_V(8); PG8_WAIT_L(0); PG8_BAR; PG8_MMA(1, 0, At, B0); PG8_MMA(1, 1, At, B1); PG8_BAR; PG8_SCHED;
            } else {
            PG8_LDB(B0, 0, 0); PG8_SCHED; PG8_LDA(At, 0, 0); PG8_STAGE(PG8_SA(1, 1), a1 + hstep, voffA);
            PG8_WAIT_L(8); PG8_BAR; PG8_WAIT_L(0); PG8_MMA(0, 0, At, B0); PG8_BAR; PG8_SCHED;
            PG8_LDB(B1, 0, 1); PG8_STAGE(PG8_SB(0, 0), b2, voffB);
            PG8_BAR; PG8_WAIT_L(0); PG8_MMA(0, 1, At, B1); PG8_BAR;
            PG8_LDA(At, 0, 1); PG8_STAGE(PG8_SA(0, 0), a2, voffA);
            PG8_BAR; PG8_WAIT_L(0); PG8_MMA(1, 0, At, B0); PG8_BAR; PG8_SCHED;
            PG8_STAGE(PG8_SB(0, 1), b2 + hstep, voffB);
            PG8_WAIT_V(6); PG8_BAR; PG8_MMA(1, 1, At, B1); PG8_BAR;
            PG8_LDB(B0, 1, 0); PG8_SCHED; PG8_LDA(At, 1, 0); PG8_STAGE(PG8_SA(0, 1), a2 + hstep, voffA);
            PG8_WAIT_L(8); PG8_BAR; PG8_WAIT_L(0); PG8_MMA(0, 0, At, B0); PG8_BAR; PG8_SCHED;
            PG8_LDB(B1, 1, 1); PG8_STAGE(PG8_SB(1, 0), b3, voffB);
            PG8_BAR; PG8_WAIT_L(0); PG8_MMA(0, 1, At, B1); PG8_BAR;
            PG8_LDA(At, 1, 1); PG8_STAGE(PG8_SA(1, 0), a3, voffA);
            PG8_BAR; PG8_WAIT_L(0); PG8_MMA(1, 0, At, B0); PG8_BAR; PG8_SCHED;
            PG8_STAGE(PG8_SB(1, 1), b3 + hstep, voffB);
            PG8_WAIT_V(6); PG8_BAR; PG8_MMA(1, 1, At, B1); PG8_BAR;
            }
        }
        if constexpr (ALIGN_EPI) { if (wr == 0) PG8_BAR; }
        if constexpr (!Epi::AFTER_DRAIN) { E(acc, cur, wr, wc, fr, fq); S.done(cur); }
        if (!has_next) break;
#pragma unroll
        for (int a = 0; a < 2; ++a)
#pragma unroll
            for (int b = 0; b < 2; ++b)
#pragma unroll
                for (int m = 0; m < 4; ++m)
#pragma unroll
                    for (int n = 0; n < 2; ++n) acc[a][b][m][n] = (f32x4){0.f, 0.f, 0.f, 0.f};
        cur = nxt; cA = nA; cB = nB; ++ui;
        if constexpr (ALIGN_EPI) { if (wr == 1) PG8_BAR; }
    }
    PG8_WAIT_V(0);
    if constexpr (!ALIGN_EPI) { if (wr == 0) PG8_BAR; }
    PG8_BAR;
    if constexpr (Epi::AFTER_DRAIN) { E.fused(acc, cur, wr, wc, fr, fq, lds, wid, lane); S.done(cur); }
#undef PG8_SA
#undef PG8_SB
#undef PG8_STAGE
#undef PG8_LDA
#undef PG8_LDB
#undef PG8_MMA
#undef PG8_WAIT_V
#undef PG8_WAIT_L
#undef PG8_BAR
#undef PG8_SCHED
}
}

#ifndef MK_ONE_LAUNCH
#define MK_ONE_LAUNCH 1
#endif
using pg8::bf16_t; using pg8::bf16x8; using pg8::f32x4; using pg8::u32x4; using pg8::Unit; using pg8::cvt_pk_bf16;
typedef unsigned u32x2 __attribute__((ext_vector_type(2)));
#define LAS __attribute__((address_space(3)))
#define DI __device__ __forceinline__

constexpr int M = 16384, D = 1024, FF = 2816, NUP = 2 * FF, NIN = 6656, SEQ = 8192, PLE = 256, POOLW = 512;
constexpr float EPS = 1e-6f;
constexpr int NWAVES = 8, NTHR = 512;
constexpr size_t MiB = 1u << 20;
constexpr size_t WS_SS0 = 0, WS_SS1 = 1 * MiB, WS_SSE = 2 * MiB, WS_DVEC = 3 * MiB, WS_LB = 3 * MiB + 512 * 1024;
constexpr size_t WS_CTL = 3 * MiB + 768 * 1024, CTL_BYTES = 16384;
constexpr size_t WS_WUP = 4 * MiB, WS_WDN = 15 * MiB, WS_WIN = 21 * MiB, WS_WA = 34 * MiB, WS_WPB = 36 * MiB, WS_WOUT = 37 * MiB, WS_WG = 39 * MiB, WS_WPLE = 41 * MiB;
constexpr size_t WS_XB = 42 * MiB, WS_PB = 74 * MiB, WS_BIG = 82 * MiB;
constexpr size_t WS_Q = WS_BIG, WS_LF = WS_BIG + 32 * MiB, WS_V = WS_BIG + 64 * MiB, WS_OG = WS_BIG + 96 * MiB, WS_S = WS_BIG + 128 * MiB;
constexpr size_t WS_U = WS_S, WS_POOLED = WS_S + 16 * MiB, WS_YA = WS_OG, WS_H = WS_BIG, WS_ERAW = WS_S, WS_END = WS_BIG + 160 * MiB;
static_assert(WS_END <= 256 * MiB, "workspace map");
static_assert(WS_WUP + (size_t)NUP * D * 2 <= WS_WDN && WS_WDN + (size_t)D * FF * 2 <= WS_WIN && WS_WIN + (size_t)NIN * D * 2 <= WS_WA, "weights map");
static_assert(WS_H + (size_t)M * FF * 2 <= WS_S, "H overlay");
constexpr int LDS_BYTES = 147456;

DI float bf2f(unsigned short h) { return __uint_as_float((unsigned)h << 16); }
DI unsigned short f2bf(float f) { return (unsigned short)(cvt_pk_bf16(f, 0.f) & 0xffffu); }
DI float silu_f(float x) { return x * __builtin_amdgcn_rcpf(1.f + __expf(-x)); }
DI float sigmoid_f(float x) { return __builtin_amdgcn_rcpf(1.f + __expf(-x)); }
DI float row_rs(const float* SS, int row, int fq) {
    const f32x4 v = *(const f32x4*)(SS + (size_t)row * 16 + fq * 4); float s = (v[0] + v[1]) + (v[2] + v[3]);
    s += __shfl_xor(s, 16); s += __shfl_xor(s, 32); return rsqrtf(s * (1.0f / D) + EPS);
}
#define ROW_OF(u, ai, m) ((u).pm * 256 + (ai) * 128 + wr * 64 + (m) * 16 + fr)

struct EpiFFN { static constexpr bool PERM = true, AFTER_DRAIN = false; bf16_t* H; const float* SS;
    DI void operator()(const f32x4 (&acc)[2][2][4][2], const Unit& u, int wr, int wc, int fr, int fq) const {
        const int col = u.pn * 128 + wc * 32 + 8 * fq;
#pragma unroll
        for (int ai = 0; ai < 2; ++ai)
#pragma unroll
            for (int m = 0; m < 4; ++m) { const int row = ROW_OF(u, ai, m); const float rs = row_rs(SS, row, fq);
                const f32x4 a0 = acc[ai][0][m][0] * rs, a1 = acc[ai][0][m][1] * rs, b0 = acc[ai][1][m][0] * rs, b1 = acc[ai][1][m][1] * rs;
                u32x4 w; w.x = cvt_pk_bf16(silu_f(a0[0]) * b0[0], silu_f(a0[1]) * b0[1]); w.y = cvt_pk_bf16(silu_f(a0[2]) * b0[2], silu_f(a0[3]) * b0[3]);
                w.z = cvt_pk_bf16(silu_f(a1[0]) * b1[0], silu_f(a1[1]) * b1[1]); w.w = cvt_pk_bf16(silu_f(a1[2]) * b1[2], silu_f(a1[3]) * b1[3]);
                *(u32x4*)(H + (size_t)row * FF + col) = w; }
    } };
struct EpiResid { static constexpr bool PERM = false, AFTER_DRAIN = false; const float* resid; float* out; bf16_t* XB; float* SSo; float alpha;
    DI void operator()(const f32x4 (&acc)[2][2][4][2], const Unit& u, int wr, int wc, int fr, int fq) const {
#pragma unroll
        for (int ai = 0; ai < 2; ++ai)
#pragma unroll
            for (int m = 0; m < 4; ++m) { const int row = ROW_OF(u, ai, m); float ss = 0.f;
#pragma unroll
                for (int bj = 0; bj < 2; ++bj)
#pragma unroll
                    for (int n = 0; n < 2; ++n) { const size_t off = (size_t)row * D + u.pn * 256 + bj * 128 + wc * 32 + 16 * n + 4 * fq;
                        const f32x4 o = *(const f32x4*)(resid + off) + acc[ai][bj][m][n] * alpha; *(f32x4*)(out + off) = o;
                        u32x2 w; w.x = cvt_pk_bf16(o[0], o[1]); w.y = cvt_pk_bf16(o[2], o[3]); *(u32x2*)(XB + off) = w;
                        ss += (o[0] * o[0] + o[1] * o[1]) + (o[2] * o[2] + o[3] * o[3]); }
                ss += __shfl_xor(ss, 16); ss += __shfl_xor(ss, 32);
                if (fq == 0) SSo[(size_t)row * 16 + u.pn * 4 + wc] = ss; }
    } };
struct Seg { bf16_t* dst; int ldc; int tile0; int act; };
struct EpiProj { static constexpr bool PERM = true, AFTER_DRAIN = false; Seg seg[4]; int nseg; const float* SS; const float* lb;
    DI void operator()(const f32x4 (&acc)[2][2][4][2], const Unit& u, int wr, int wc, int fr, int fq) const {
        Seg s = seg[0];
#pragma unroll
        for (int i = 1; i < 4; ++i) if (i < nseg && u.pn >= seg[i].tile0) s = seg[i];
        const int col0 = (u.pn - s.tile0) * 256 + wc * 32 + 8 * fq;
        f32x4 l0[2], l1[2];
#pragma unroll
        for (int bj = 0; bj < 2; ++bj) { if (s.act == 3) { l0[bj] = *(const f32x4*)(lb + col0 + bj * 128); l1[bj] = *(const f32x4*)(lb + col0 + bj * 128 + 4); } else { l0[bj] = (f32x4){0.f, 0.f, 0.f, 0.f}; l1[bj] = l0[bj]; } }
#pragma unroll
        for (int ai = 0; ai < 2; ++ai)
#pragma unroll
            for (int m = 0; m < 4; ++m) { const int row = ROW_OF(u, ai, m); const float rs = row_rs(SS, row, fq);
#pragma unroll
                for (int bj = 0; bj < 2; ++bj) { f32x4 v0 = acc[ai][bj][m][0] * rs, v1 = acc[ai][bj][m][1] * rs;
                    if (s.act == 1) {
#pragma unroll
                        for (int i = 0; i < 4; ++i) { v0[i] = silu_f(v0[i]); v1[i] = silu_f(v1[i]); }
                    } else if (s.act == 2) {
#pragma unroll
                        for (int i = 0; i < 4; ++i) { v0[i] = sigmoid_f(v0[i]); v1[i] = sigmoid_f(v1[i]); }
                    } else if (s.act == 3) {
#pragma unroll
                        for (int i = 0; i < 4; ++i) { v0[i] = __logf(l0[bj][i] + (1.f - l0[bj][i]) * sigmoid_f(v0[i])); v1[i] = __logf(l1[bj][i] + (1.f - l1[bj][i]) * sigmoid_f(v1[i])); }
                    }
                    u32x4 w; w.x = cvt_pk_bf16(v0[0], v0[1]); w.y = cvt_pk_bf16(v0[2], v0[3]); w.z = cvt_pk_bf16(v1[0], v1[1]); w.w = cvt_pk_bf16(v1[2], v1[3]);
                    *(u32x4*)(s.dst + (size_t)row * s.ldc + col0 + bj * 128) = w; } }
    } };
struct EpiGate { static constexpr bool PERM = true, AFTER_DRAIN = false; const bf16_t* gate; const bf16_t* add; bf16_t* out;
    DI void operator()(const f32x4 (&acc)[2][2][4][2], const Unit& u, int wr, int wc, int fr, int fq) const {
#pragma unroll
        for (int ai = 0; ai < 2; ++ai)
#pragma unroll
            for (int m = 0; m < 4; ++m) { const int row = ROW_OF(u, ai, m);
#pragma unroll
                for (int bj = 0; bj < 2; ++bj) { const size_t off = (size_t)row * D + u.pn * 256 + bj * 128 + wc * 32 + 8 * fq;
                    const u32x4 g = *(const u32x4*)(gate + off); u32x4 a = (u32x4){0u, 0u, 0u, 0u}; if (add) a = *(const u32x4*)(add + off);
                    const f32x4 v0 = acc[ai][bj][m][0], v1 = acc[ai][bj][m][1]; u32x4 w;
                    w.x = cvt_pk_bf16(__uint_as_float(a.x << 16) + __uint_as_float(g.x << 16) * v0[0], __uint_as_float(a.x & 0xffff0000u) + __uint_as_float(g.x & 0xffff0000u) * v0[1]);
                    w.y = cvt_pk_bf16(__uint_as_float(a.y << 16) + __uint_as_float(g.y << 16) * v0[2], __uint_as_float(a.y & 0xffff0000u) + __uint_as_float(g.y & 0xffff0000u) * v0[3]);
                    w.z = cvt_pk_bf16(__uint_as_float(a.z << 16) + __uint_as_float(g.z << 16) * v1[0], __uint_as_float(a.z & 0xffff0000u) + __uint_as_float(g.z & 0xffff0000u) * v1[1]);
                    w.w = cvt_pk_bf16(__uint_as_float(a.w << 16) + __uint_as_float(g.w << 16) * v1[2], __uint_as_float(a.w & 0xffff0000u) + __uint_as_float(g.w & 0xffff0000u) * v1[3]);
                    *(u32x4*)(out + off) = w; } }
    } };
struct EpiEraw { static constexpr bool PERM = true, AFTER_DRAIN = false; bf16_t* E; float* SSo;
    DI void operator()(const f32x4 (&acc)[2][2][4][2], const Unit& u, int wr, int wc, int fr, int fq) const {
#pragma unroll
        for (int ai = 0; ai < 2; ++ai)
#pragma unroll
            for (int m = 0; m < 4; ++m) { const int row = ROW_OF(u, ai, m); float ss = 0.f;
#pragma unroll
                for (int bj = 0; bj < 2; ++bj) { const size_t off = (size_t)row * D + u.pn * 256 + bj * 128 + wc * 32 + 8 * fq; const f32x4 v0 = acc[ai][bj][m][0], v1 = acc[ai][bj][m][1];
                    u32x4 w; w.x = cvt_pk_bf16(v0[0], v0[1]); w.y = cvt_pk_bf16(v0[2], v0[3]); w.z = cvt_pk_bf16(v1[0], v1[1]); w.w = cvt_pk_bf16(v1[2], v1[3]); *(u32x4*)(E + off) = w;
                    ss += (v0[0] * v0[0] + v0[1] * v0[1]) + (v0[2] * v0[2] + v0[3] * v0[3]) + (v1[0] * v1[0] + v1[1] * v1[1]) + (v1[2] * v1[2] + v1[3] * v1[3]); }
                ss += __shfl_xor(ss, 16); ss += __shfl_xor(ss, 32);
                if (fq == 0) SSo[(size_t)row * 16 + u.pn * 4 + wc] = ss; }
    } };
struct EpiPle { static constexpr bool PERM = false, AFTER_DRAIN = false; float* x; const bf16_t* E; const float* SS; const float* SSe; const float* gpost; float* SSo;
    DI void operator()(const f32x4 (&acc)[2][2][4][2], const Unit& u, int wr, int wc, int fr, int fq) const {
#pragma unroll
        for (int ai = 0; ai < 2; ++ai)
#pragma unroll
            for (int m = 0; m < 4; ++m) { const int row = ROW_OF(u, ai, m); const float rs = row_rs(SS, row, fq), rse = row_rs(SSe, row, fq); float ss = 0.f;
#pragma unroll
                for (int bj = 0; bj < 2; ++bj)
#pragma unroll
                    for (int n = 0; n < 2; ++n) { const int col = u.pn * 256 + bj * 128 + wc * 32 + 16 * n + 4 * fq; const size_t off = (size_t)row * D + col;
                        const u32x2 e = *(const u32x2*)(E + off); const f32x4 gp = *(const f32x4*)(gpost + col); const f32x4 a = acc[ai][bj][m][n] * rs; f32x4 o = *(const f32x4*)(x + off);
                        o[0] += sigmoid_f(a[0]) * (__uint_as_float(e.x << 16) * rse * gp[0]); o[1] += sigmoid_f(a[1]) * (__uint_as_float(e.x & 0xffff0000u) * rse * gp[1]);
                        o[2] += sigmoid_f(a[2]) * (__uint_as_float(e.y << 16) * rse * gp[2]); o[3] += sigmoid_f(a[3]) * (__uint_as_float(e.y & 0xffff0000u) * rse * gp[3]);
                        *(f32x4*)(x + off) = o; ss += (o[0] * o[0] + o[1] * o[1]) + (o[2] * o[2] + o[3] * o[3]); }
                ss += __shfl_xor(ss, 16); ss += __shfl_xor(ss, 32);
                if (fq == 0) SSo[(size_t)row * 16 + u.pn * 4 + wc] = ss; }
    } };

DI float wave_sum(float v) {
#pragma unroll
    for (int o = 1; o < 64; o <<= 1) v += __shfl_xor(v, o);
    return v;
}
DI void transpose_item(const float* W, int ldw, int k0, int ns0, bf16_t* WT, int Kd, int drow0, const float* g, LAS float* scr, int lane) {
#pragma unroll 8
    for (int i = 0; i < 32; ++i) { const int kk = 2 * i + (lane >> 5); float w = W[(size_t)(k0 + kk) * ldw + ns0 + (lane & 31)]; if (g) w *= g[k0 + kk]; scr[kk * 33 + (lane & 31)] = w; }
    asm volatile("s_waitcnt lgkmcnt(0)" ::: "memory");
    const int c = lane & 7;
#pragma unroll
    for (int j = 0; j < 4; ++j) { const int n = (lane >> 3) + 8 * j; const LAS float* s = scr + (8 * c) * 33 + n;
        u32x4 o; o.x = cvt_pk_bf16(s[0 * 33], s[1 * 33]); o.y = cvt_pk_bf16(s[2 * 33], s[3 * 33]); o.z = cvt_pk_bf16(s[4 * 33], s[5 * 33]); o.w = cvt_pk_bf16(s[6 * 33], s[7 * 33]);
        *(u32x4*)(WT + (size_t)(drow0 + n) * Kd + k0 + 8 * c) = o; }
    asm volatile("s_waitcnt lgkmcnt(0)" ::: "memory");
}
DI void transpose_job(const float* W, int K, int N, bf16_t* WT, const float* g, LAS float* scr, int lane, int gw, int NGW, int& base) {
    const int nblk = N / 32, nit = (K / 64) * nblk;
    for (int it = ((gw - base) % NGW + NGW) % NGW; it < nit; it += NGW) { const int kb = it / nblk, nb = it % nblk; transpose_item(W, N, 64 * kb, 32 * nb, WT, K, 32 * nb, g, scr, lane); }
    base = (base + nit) % NGW;
}
DI void transpose_up_job(const float* W1, const float* W3, bf16_t* WT, const float* g, LAS float* scr, int lane, int gw, int NGW, int& base) {
    const int nblk = NUP / 32, nit = (D / 64) * nblk;
    for (int it = ((gw - base) % NGW + NGW) % NGW; it < nit; it += NGW) { const int kb = it / nblk, nb = it % nblk, j = nb >> 3, rr = nb & 7;
        transpose_item(rr < 4 ? W1 : W3, FF, 64 * kb, 128 * j + 32 * (rr & 3), WT, D, 32 * nb, g, scr, lane); }
    base = (base + nit) % NGW;
}

constexpr int HP = 272;
#define MFMA16(a, b, c) __builtin_amdgcn_mfma_f32_16x16x32_bf16((a), (b), (c), 0, 0, 0)
constexpr int HR = 128 * HP;
DI void hgrn_a_unit(LAS unsigned char* lds, int uidx, const bf16_t* LF, const bf16_t* V, bf16_t* S, float* dvec, int tid) {
    const int bh = uidx >> 6, nb = uidx & 63, b = bh >> 3, h = bh & 7;
    const size_t tb = ((size_t)b * SEQ + nb * 128) * D + h * 128;
    LAS unsigned char* R0 = lds; LAS unsigned char* R1 = lds + HR; LAS unsigned char* R2 = lds + 2 * HR; LAS unsigned char* R3 = lds + 3 * HR; LAS float* segtot = (LAS float*)(lds + 4 * HR);
    { u32x4 rl[4], rv[4];
#pragma unroll
      for (int j = 0; j < 4; ++j) { const int id = tid + 512 * j, row = id >> 4, cc = id & 15; const size_t go = tb + (size_t)row * D + cc * 8; rl[j] = *(const u32x4*)(LF + go); rv[j] = *(const u32x4*)(V + go); }
#pragma unroll
      for (int j = 0; j < 4; ++j) { const int id = tid + 512 * j, row = id >> 4, cc = id & 15; *(LAS u32x4*)(R1 + row * HP + cc * 16) = rl[j]; *(LAS u32x4*)(R2 + row * HP + cc * 16) = rv[j]; } }
    __syncthreads();
    const int c = tid & 127, seg = tid >> 7;
    const LAS unsigned char* colL = R1 + (seg * 32) * HP + c * 2; const LAS unsigned char* colV = R2 + (seg * 32) * HP + c * 2;
    float lfv[32], G[32]; float run = 0.f;
#pragma unroll
    for (int i = 0; i < 32; ++i) { const float x = bf2f(*(const LAS unsigned short*)(colL + i * HP)); lfv[i] = x; run += x; G[i] = run; }
    segtot[seg * 128 + c] = run;
    __syncthreads();
    const float t0 = segtot[c], t1 = segtot[128 + c], t2 = segtot[256 + c], t3 = segtot[384 + c];
    const float off = seg == 0 ? 0.f : seg == 1 ? t0 : seg == 2 ? t0 + t1 : t0 + t1 + t2;
    const float glast = (t0 + t1) + (t2 + t3);
    if (seg == 0) dvec[(size_t)uidx * 128 + c] = __expf(glast);
#pragma unroll
    for (int j = 0; j < 4; ++j) { float kd[8], vv[8];
#pragma unroll
        for (int e = 0; e < 8; ++e) { const int i = 8 * j + e; kd[e] = (1.f - __expf(lfv[i])) * __expf(glast - (off + G[i])); vv[e] = bf2f(*(const LAS unsigned short*)(colV + i * HP)); }
        u32x4 wk, wv; wk.x = cvt_pk_bf16(kd[0], kd[1]); wk.y = cvt_pk_bf16(kd[2], kd[3]); wk.z = cvt_pk_bf16(kd[4], kd[5]); wk.w = cvt_pk_bf16(kd[6], kd[7]);
        wv.x = cvt_pk_bf16(vv[0], vv[1]); wv.y = cvt_pk_bf16(vv[2], vv[3]); wv.z = cvt_pk_bf16(vv[4], vv[5]); wv.w = cvt_pk_bf16(vv[6], vv[7]);
        *(LAS u32x4*)(R0 + c * HP + (seg * 32 + 8 * j) * 2) = wk; *(LAS u32x4*)(R3 + c * HP + (seg * 32 + 8 * j) * 2) = wv; }
    __syncthreads();
    const int w = __builtin_amdgcn_readfirstlane(tid >> 6), lane = tid & 63, r = lane & 15, quad = lane >> 4;
    bf16x8 av[4];
#pragma unroll
    for (int ks = 0; ks < 4; ++ks) av[ks] = *(const LAS bf16x8*)(R3 + (16 * w + r) * HP + (ks * 32 + quad * 8) * 2);
#pragma unroll
    for (int kt = 0; kt < 8; ++kt) { f32x4 a = (f32x4){0.f, 0.f, 0.f, 0.f};
#pragma unroll
        for (int ks = 0; ks < 4; ++ks) { const bf16x8 bk = *(const LAS bf16x8*)(R0 + (16 * kt + r) * HP + (ks * 32 + quad * 8) * 2); a = MFMA16(av[ks], bk, a); }
#pragma unroll
        for (int j = 0; j < 4; ++j) *(LAS unsigned short*)(R1 + (16 * w + quad * 4 + j) * HP + (16 * kt + r) * 2) = f2bf(a[j]); }
    bf16_t* So = S + (size_t)uidx * 16384;
#pragma unroll
    for (int j = 0; j < 4; ++j) { const int q = lane + 64 * j, row = q >> 4, cc = q & 15; const u32x4 v = *(const LAS u32x4*)(R1 + (16 * w + row) * HP + cc * 16); *(u32x4*)(So + (16 * w + row) * 128 + cc * 8) = v; }
    __syncthreads();
}
DI void hgrn_scan(bf16_t* S, const float* dvec, int gtid, int nthr) {
    typedef float f32x2s __attribute__((ext_vector_type(2)));
    for (int item = gtid; item < 16 * 128 * 64; item += nthr) { const int bh = item >> 13, rem = item & 8191, v = rem >> 6, kp = rem & 63;
        unsigned* base = (unsigned*)(S + (size_t)bh * 64 * 16384 + v * 128 + kp * 2); const float* dv = dvec + (size_t)bh * 64 * 128 + kp * 2;
        float s0 = 0.f, s1 = 0.f;
        unsigned dA[16], dB[16]; f32x2s cA[16], cB[16];
#define SCAN_LOAD(d, c, nb) _Pragma("unroll") for (int i = 0; i < 16; ++i) { d[i] = base[(size_t)((nb) + i) * 8192]; c[i] = *(const f32x2s*)(dv + ((nb) + i) * 128); }
#define SCAN_STEP(d, c, nb) _Pragma("unroll") for (int i = 0; i < 16; ++i) { base[(size_t)((nb) + i) * 8192] = cvt_pk_bf16(s0, s1); s0 = c[i][0] * s0 + __uint_as_float(d[i] << 16); s1 = c[i][1] * s1 + __uint_as_float(d[i] & 0xffff0000u); }
        SCAN_LOAD(dA, cA, 0)
        SCAN_LOAD(dB, cB, 16) SCAN_STEP(dA, cA, 0)
        SCAN_LOAD(dA, cA, 32) SCAN_STEP(dB, cB, 16)
        SCAN_LOAD(dB, cB, 48) SCAN_STEP(dA, cA, 32)
        SCAN_STEP(dB, cB, 48)
#undef SCAN_LOAD
#undef SCAN_STEP
    }
}
DI void hgrn_c_unit(LAS unsigned char* lds, int uidx, const bf16_t* Q, const bf16_t* LF, const bf16_t* V, const bf16_t* OG, const bf16_t* S, const float* onorm, bf16_t* OUT, int tid) {
    const int bh = uidx >> 6, nb = uidx & 63, b = bh >> 3, h = bh & 7;
    const int colbase = h * 128; const size_t tb = ((size_t)b * SEQ + nb * 128) * D + colbase;
    LAS unsigned char* R0 = lds; LAS unsigned char* R1 = lds + HR; LAS unsigned char* R2 = lds + 2 * HR; LAS unsigned char* R3 = lds + 3 * HR; LAS float* segtot = (LAS float*)(lds + 4 * HR); LAS float* eg = segtot + 512;
    const bf16_t* Su = S + (size_t)uidx * 16384;
    u32x4 rsv[4], rog[4];
    { u32x4 rl[4], rq[4], rv[4];
#pragma unroll
      for (int j = 0; j < 4; ++j) { const int id = tid + 512 * j, row = id >> 4, cc = id & 15; const size_t go = tb + (size_t)row * D + cc * 8;
          rl[j] = *(const u32x4*)(LF + go); rq[j] = *(const u32x4*)(Q + go); rv[j] = *(const u32x4*)(V + go); rog[j] = *(const u32x4*)(OG + go); rsv[j] = *(const u32x4*)(Su + row * 128 + cc * 8); }
#pragma unroll
      for (int j = 0; j < 4; ++j) { const int id = tid + 512 * j, row = id >> 4, cc = id & 15; *(LAS u32x4*)(R1 + row * HP + cc * 16) = rl[j]; *(LAS u32x4*)(R0 + row * HP + cc * 16) = rq[j]; *(LAS u32x4*)(R2 + row * HP + cc * 16) = rv[j]; } }
    __syncthreads();
    const int c = tid & 127, seg = tid >> 7;
    LAS unsigned char* colL = R1 + (seg * 32) * HP + c * 2; LAS unsigned char* colQ = R0 + (seg * 32) * HP + c * 2; const LAS unsigned char* colV = R2 + (seg * 32) * HP + c * 2;
    float lfv[32], G[32]; float run = 0.f;
#pragma unroll
    for (int i = 0; i < 32; ++i) { const float x = bf2f(*(const LAS unsigned short*)(colL + i * HP)); lfv[i] = x; run += x; G[i] = run; }
    segtot[seg * 128 + c] = run;
    __syncthreads();
    const float t0 = segtot[c], t1 = segtot[128 + c], t2 = segtot[256 + c];
    const float off = seg == 0 ? 0.f : seg == 1 ? t0 : seg == 2 ? t0 + t1 : t0 + t1 + t2;
    const float gref = t0 + t1;
    if (seg == 0) eg[c] = __expf(gref);
#pragma unroll
    for (int i = 0; i < 32; ++i) { const float g = off + G[i]; const float q = bf2f(*(const LAS unsigned short*)(colQ + i * HP)); const float kk = 1.f - __expf(lfv[i]);
        *(LAS unsigned short*)(colQ + i * HP) = f2bf(q * __expf(g - gref)); *(LAS unsigned short*)(colL + i * HP) = f2bf(kk * __expf(gref - g)); }
#pragma unroll
    for (int j = 0; j < 4; ++j) { float vv[8];
#pragma unroll
        for (int e = 0; e < 8; ++e) vv[e] = bf2f(*(const LAS unsigned short*)(colV + (8 * j + e) * HP));
        u32x4 wv; wv.x = cvt_pk_bf16(vv[0], vv[1]); wv.y = cvt_pk_bf16(vv[2], vv[3]); wv.z = cvt_pk_bf16(vv[4], vv[5]); wv.w = cvt_pk_bf16(vv[6], vv[7]);
        *(LAS u32x4*)(R3 + c * HP + (seg * 32 + 8 * j) * 2) = wv; }
    __syncthreads();
#pragma unroll
    for (int j = 0; j < 4; ++j) { const int id = tid + 512 * j, row = id >> 4, cc = id & 15; *(LAS u32x4*)(R2 + row * HP + cc * 16) = rsv[j]; }
    const int w = __builtin_amdgcn_readfirstlane(tid >> 6), lane = tid & 63, r = lane & 15, quad = lane >> 4;
    bf16x8 aq[4];
#pragma unroll
    for (int ks = 0; ks < 4; ++ks) aq[ks] = *(const LAS bf16x8*)(R0 + (16 * w + r) * HP + (ks * 32 + quad * 8) * 2);
    for (int st = 0; st <= w; ++st) { f32x4 sc = (f32x4){0.f, 0.f, 0.f, 0.f};
#pragma unroll
        for (int ks = 0; ks < 4; ++ks) { const bf16x8 bk = *(const LAS bf16x8*)(R1 + (16 * st + r) * HP + (ks * 32 + quad * 8) * 2); sc = MFMA16(aq[ks], bk, sc); }
#pragma unroll
        for (int j = 0; j < 4; ++j) { const int t = quad * 4 + j; const bool keep = (st < w) || (r <= t); *(LAS unsigned short*)(R0 + (16 * w + t) * HP + (16 * st + r) * 2) = keep ? f2bf(sc[j]) : (unsigned short)0; } }
    if ((w & 1) == 0) {
#pragma unroll
        for (int j = 0; j < 4; ++j) *(LAS unsigned short*)(R0 + (16 * w + quad * 4 + j) * HP + (16 * (w + 1) + r) * 2) = (unsigned short)0; }
    f32x4 o[8];
#pragma unroll
    for (int vt = 0; vt < 8; ++vt) o[vt] = (f32x4){0.f, 0.f, 0.f, 0.f};
    const int nks2 = (w >> 1) + 1;
    for (int ks2 = 0; ks2 < nks2; ++ks2) { const bf16x8 ap = *(const LAS bf16x8*)(R0 + (16 * w + r) * HP + (ks2 * 32 + quad * 8) * 2);
#pragma unroll
        for (int vt = 0; vt < 8; ++vt) { const bf16x8 bv = *(const LAS bf16x8*)(R3 + (16 * vt + r) * HP + (ks2 * 32 + quad * 8) * 2); o[vt] = MFMA16(ap, bv, o[vt]); } }
    __syncthreads();
#pragma unroll
    for (int j = 0; j < 4; ++j) { const int id = tid + 512 * j, row = id >> 4, cc = id & 15; *(LAS u32x4*)(R1 + row * HP + cc * 16) = rog[j]; }
#pragma unroll
    for (int ks = 0; ks < 4; ++ks) { const f32x4 e0 = *(const LAS f32x4*)(eg + ks * 32 + quad * 8), e1 = *(const LAS f32x4*)(eg + ks * 32 + quad * 8 + 4);
        const u32x4 qa = __builtin_bit_cast(u32x4, aq[ks]); u32x4 qs;
        qs.x = cvt_pk_bf16(__uint_as_float(qa.x << 16) * e0[0], __uint_as_float(qa.x & 0xffff0000u) * e0[1]); qs.y = cvt_pk_bf16(__uint_as_float(qa.y << 16) * e0[2], __uint_as_float(qa.y & 0xffff0000u) * e0[3]);
        qs.z = cvt_pk_bf16(__uint_as_float(qa.z << 16) * e1[0], __uint_as_float(qa.z & 0xffff0000u) * e1[1]); qs.w = cvt_pk_bf16(__uint_as_float(qa.w << 16) * e1[2], __uint_as_float(qa.w & 0xffff0000u) * e1[3]);
        const bf16x8 aqg = __builtin_bit_cast(bf16x8, qs);
#pragma unroll
        for (int vt = 0; vt < 8; ++vt) { const bf16x8 bs = *(const LAS bf16x8*)(R2 + (16 * vt + r) * HP + (ks * 32 + quad * 8) * 2); o[vt] = MFMA16(aqg, bs, o[vt]); } }
    float rstd[4];
#pragma unroll
    for (int j = 0; j < 4; ++j) { float ss = 0.f;
#pragma unroll
        for (int vt = 0; vt < 8; ++vt) ss += o[vt][j] * o[vt][j];
        ss += __shfl_xor(ss, 1); ss += __shfl_xor(ss, 2); ss += __shfl_xor(ss, 4); ss += __shfl_xor(ss, 8); rstd[j] = rsqrtf(ss * (1.0f / 128.0f) + EPS); }
    __syncthreads();
#pragma unroll
    for (int vt = 0; vt < 8; ++vt) { const float gn = onorm[colbase + 16 * vt + r];
#pragma unroll
        for (int j = 0; j < 4; ++j) { const int t = 16 * w + quad * 4 + j, v = 16 * vt + r; const float og = bf2f(*(const LAS unsigned short*)(R1 + t * HP + v * 2));
            *(LAS unsigned short*)(R0 + t * HP + v * 2) = f2bf(o[vt][j] * rstd[j] * gn * og); } }
#pragma unroll
    for (int j = 0; j < 4; ++j) { const int q = lane + 64 * j, row = q >> 4, cc = q & 15; const u32x4 v = *(const LAS u32x4*)(R0 + (16 * w + row) * HP + cc * 16); *(u32x4*)(OUT + tb + (size_t)(16 * w + row) * D + cc * 8) = v; }
    __syncthreads();
}

#define XB_TMO      128
#define XB_XCNT(j)  (256  + 64 * (j))
#define XB_XSUB(j)  (1280 + 64 * (j))
#define XB_XGEN(j)  (2304 + 64 * (j))
#define XB_TOP      3328
#define XB_TOPGEN   3392
#define XCD_BAR_WORDS 3456
#define XB_SPIN_CAP (1u << 18)

__device__ __forceinline__ unsigned xb_ld(unsigned* p)              { return __hip_atomic_load(p, __ATOMIC_RELAXED, __HIP_MEMORY_SCOPE_AGENT); }
__device__ __forceinline__ unsigned xb_add(unsigned* p, unsigned v) { return __hip_atomic_fetch_add(p, v, __ATOMIC_RELAXED, __HIP_MEMORY_SCOPE_AGENT); }
__device__ __forceinline__ unsigned xb_xcc_id() { return (unsigned)__builtin_amdgcn_s_getreg((3 << 11) | 20) & 0xFu; }
#define XB_SPIN(cond, bar) do { unsigned _sp = 0; while (cond) { __builtin_amdgcn_s_sleep(1); \
    if ((++_sp & 255u) == 0u) { if (xb_ld(&(bar)[XB_TMO])) break; if (_sp > XB_SPIN_CAP) { atomicAdd(&(bar)[XB_TMO], 1u); break; } } } } while (0)

struct XcdBarrier {
    unsigned* bar; unsigned x;
    volatile LAS unsigned* st;
};

__device__ __forceinline__ XcdBarrier xcd_barrier_post(unsigned* bar, volatile LAS unsigned* st) {
    XcdBarrier b; b.bar = bar; b.x = xb_xcc_id(); b.st = st;
    if (threadIdx.x == 0) (void)xb_add(&bar[XB_XCNT(b.x)], 1u);
    return b;
}
__device__ __forceinline__ void xcd_barrier_complete(unsigned* bar, unsigned x, unsigned& nloc, unsigned& nx) {
    const unsigned G = gridDim.x * gridDim.y * gridDim.z;
    unsigned sum, cnt, mine, sp = 0u;
    for (;;) {
        sum = 0u; cnt = 0u; mine = 0u;
#pragma unroll
        for (unsigned j = 0; j < 16; ++j) { const unsigned c = xb_ld(&bar[XB_XCNT(j)]); sum += c; cnt += (c > 0u) ? 1u : 0u; mine = (j == x) ? c : mine; }
        if (sum == G) break;
        __builtin_amdgcn_s_sleep(1);
        if ((++sp & 255u) == 0u) { if (xb_ld(&bar[XB_TMO])) break; if (sp > XB_SPIN_CAP) { atomicAdd(&bar[XB_TMO], 1u); break; } }
    }
    nloc = mine > 0u ? mine : 1u; nx = cnt > 0u ? cnt : 1u;
}

__device__ __forceinline__ void xcd_barrier(const XcdBarrier& b) {
    asm volatile("s_waitcnt vmcnt(0)" ::: "memory");
    __syncthreads();
    if (threadIdx.x == 0) {
        unsigned* bar = b.bar;
        __builtin_amdgcn_s_waitcnt(0);
        unsigned nloc = b.st[0], nx = b.st[1];
        if (nloc == 0u) { xcd_barrier_complete(bar, b.x, nloc, nx); b.st[0] = nloc; b.st[1] = nx; }
        const unsigned old = xb_add(&bar[XB_XSUB(b.x)], 1u);
        const unsigned gen = old / nloc;
        if (old + 1u == (gen + 1u) * nloc) {
            __builtin_amdgcn_fence(__ATOMIC_RELEASE, "agent");
            asm volatile("s_waitcnt vmcnt(0)" ::: "memory");
            const unsigned og = xb_add(&bar[XB_TOP], 1u);
            const unsigned tg = og / nx;
            if (og + 1u == (tg + 1u) * nx) xb_add(&bar[XB_TOPGEN], 1u);
            else XB_SPIN(xb_ld(&bar[XB_TOPGEN]) == tg, bar);
            __builtin_amdgcn_fence(__ATOMIC_ACQUIRE, "agent");
            xb_add(&bar[XB_XGEN(b.x)], 1u);
            asm volatile("s_waitcnt vmcnt(0)" ::: "memory");
        } else {
            XB_SPIN(xb_ld(&bar[XB_XGEN(b.x)]) == gen, bar);
            __builtin_amdgcn_fence(__ATOMIC_ACQUIRE, "agent");
            asm volatile("s_waitcnt vmcnt(0)" ::: "memory");
        }
    }
    __syncthreads();
}

#ifndef REP_P0
#define REP_P0 1
#endif
#ifndef REP_POOL
#define REP_POOL 1
#endif
#ifndef REP_G1
#define REP_G1 1
#endif
#ifndef REP_G2
#define REP_G2 1
#endif
#ifndef REP_HC
#define REP_HC 1
#endif
#ifndef REP_TR
#define REP_TR 1
#endif
#ifndef REP_BAR
#define REP_BAR 1
#endif
#ifndef REP_G3B
#define REP_G3B 1
#endif
#ifndef REP_G4A
#define REP_G4A 1
#endif
#ifndef REP_HA
#define REP_HA 1
#endif
#ifndef REP_G3A
#define REP_G3A 1
#endif
struct Args { const float* in[24]; float* out; unsigned char* ws; int ph_lo, ph_hi; };
enum { P_PRO = 0, P_G1, P_G2, P_G3A, P_HA, P_SCAN, P_HC, P_G3B, P_POOL, P_G4A, P_G4B, P_G5, P_G6, P_G7, P_G8A, P_G8B, P_FIN, P_N };
enum { I_X = 0, I_P, I_F1N, I_F1W1, I_F1W3, I_F1W2, I_MIXN, I_WIN, I_LB, I_ONORM, I_WA, I_POOLW, I_POOLS, I_WB, I_WOUT, I_F2N, I_F2W1, I_F2W3, I_F2W2, I_PLEN, I_PLEG, I_PLEP, I_PLEPOST, I_FINN };

template <class Epi> DI void run_gemm(LAS unsigned char* lds, const bf16_t* A, const bf16_t* Bt, int N, int K, const Epi& E) {
    pg8::Gemm g{A, Bt, M, N, K}; pg8::StaticOrder S; S.init(M, N, (int)gridDim.x, (int)blockIdx.x);
    pg8::gemm_phase<Epi, pg8::StaticOrder, true, true>(lds, g, S, E);
}

__global__ void __launch_bounds__(NTHR, 2) fwd_kernel(Args args) {
    extern __shared__ __attribute__((aligned(16))) unsigned char lds_raw[];
    LAS unsigned char* lds = (LAS unsigned char*)lds_raw;
    const int tid = threadIdx.x, wave = __builtin_amdgcn_readfirstlane(tid >> 6);
#define FRESH_LANE() ({ int t_ = threadIdx.x; asm volatile("" : "+v"(t_)); t_ & 63; })
    const int G = gridDim.x, gw = blockIdx.x * NWAVES + wave, NGW = G * NWAVES, gtid = blockIdx.x * NTHR + tid, nthr = G * NTHR;
    unsigned char* ws = args.ws;
    float* SS0 = (float*)(ws + WS_SS0); float* SS1 = (float*)(ws + WS_SS1); float* SSE = (float*)(ws + WS_SSE); float* DVEC = (float*)(ws + WS_DVEC); float* LB = (float*)(ws + WS_LB);
    bf16_t* WUP = (bf16_t*)(ws + WS_WUP); bf16_t* WDN = (bf16_t*)(ws + WS_WDN); bf16_t* WIN = (bf16_t*)(ws + WS_WIN); bf16_t* WA = (bf16_t*)(ws + WS_WA); bf16_t* WPB = (bf16_t*)(ws + WS_WPB);
    bf16_t* WOUT = (bf16_t*)(ws + WS_WOUT); bf16_t* WG = (bf16_t*)(ws + WS_WG); bf16_t* WPLE = (bf16_t*)(ws + WS_WPLE);
    bf16_t* XB = (bf16_t*)(ws + WS_XB); bf16_t* PB = (bf16_t*)(ws + WS_PB);
    bf16_t* Qb = (bf16_t*)(ws + WS_Q); bf16_t* LFb = (bf16_t*)(ws + WS_LF); bf16_t* Vb = (bf16_t*)(ws + WS_V); bf16_t* OGb = (bf16_t*)(ws + WS_OG); bf16_t* Sb = (bf16_t*)(ws + WS_S);
    bf16_t* Ub = (bf16_t*)(ws + WS_U); bf16_t* POOLED = (bf16_t*)(ws + WS_POOLED); bf16_t* YA = (bf16_t*)(ws + WS_YA); bf16_t* Hb = (bf16_t*)(ws + WS_H); bf16_t* ERAW = (bf16_t*)(ws + WS_ERAW);
    float* X = args.out;
    cg::grid_group grid = cg::this_grid();
    volatile LAS unsigned* MISC = (volatile LAS unsigned*)(lds + LDS_BYTES - 64);
    if (tid < 2) MISC[tid] = 0u;
    __syncthreads();
    XcdBarrier bar = xcd_barrier_post((unsigned*)(ws + WS_CTL), MISC);
    if (args.ph_lo < 0) grid.sync();

    const int lo = args.ph_lo, hi = args.ph_hi;
#define IN(k) (lo <= (k) && (k) < hi)
#define SEAM(k) do { if ((k) + 1 < hi) xcd_barrier(bar); } while (0)
        if (IN(P_PRO)) { for (int rep = 0; rep < REP_P0; ++rep) { const int lane = FRESH_LANE();
            LAS float* scr = (LAS float*)(lds + wave * 16384);
            int base = 0;
            transpose_up_job(args.in[I_F1W1], args.in[I_F1W3], WUP, args.in[I_F1N], scr, lane, gw, NGW, base);
            transpose_job(args.in[I_F1W2], FF, D, WDN, nullptr, scr, lane, gw, NGW, base);
            transpose_job(args.in[I_WIN], D, NIN, WIN, args.in[I_MIXN], scr, lane, gw, NGW, base);
            transpose_job(args.in[I_WA], D, D, WA, nullptr, scr, lane, gw, NGW, base);
            transpose_job(args.in[I_WOUT], D, D, WOUT, nullptr, scr, lane, gw, NGW, base);
            transpose_job(args.in[I_PLEG], D, D, WG, args.in[I_PLEN], scr, lane, gw, NGW, base);
            transpose_job(args.in[I_PLEP], PLE, D, WPLE, nullptr, scr, lane, gw, NGW, base);
            { const float* pw = args.in[I_POOLW]; const float* ps = args.in[I_POOLS]; const float* wb = args.in[I_WB];
              for (int it = gtid; it < POOLW * D; it += nthr) { const int gc = it >> 10, n = it & 1023, g = gc >> 7; float a = 0.f;
                  for (int d = 0; d < 128; ++d) a += pw[(size_t)gc * 128 + d] * ps[g * 128 + d] * wb[(size_t)(g * 128 + d) * D + n];
                  WPB[(size_t)n * POOLW + gc] = f2bf(a); } }
            { const float* hl = args.in[I_LB]; for (int k = gtid; k < D; k += nthr) LB[k] = 1.f / (1.f + __expf(hl[D + k] - hl[k])); }
            { const float* x = args.in[I_X];
              for (int m = gw; m < M; m += NGW) { const f32x4* xr = (const f32x4*)(x + (size_t)m * D) + lane; float s = 0.f; unsigned long long* o8 = (unsigned long long*)(XB + (size_t)m * D) + lane;
#pragma unroll
                  for (int j = 0; j < 4; ++j) { const f32x4 v = xr[64 * j]; s += (v[0] * v[0] + v[1] * v[1]) + (v[2] * v[2] + v[3] * v[3]); o8[64 * j] = (unsigned long long)cvt_pk_bf16(v[0], v[1]) | ((unsigned long long)cvt_pk_bf16(v[2], v[3]) << 32); }
                  s = wave_sum(s); if (lane < 16) SS0[(size_t)m * 16 + lane] = lane == 0 ? s : 0.f; } }
            { const f32x4* p4 = (const f32x4*)args.in[I_P]; u32x2* o = (u32x2*)PB;
              for (int i = gtid; i < M * PLE / 4; i += nthr) { const f32x4 v = p4[i]; u32x2 w; w.x = cvt_pk_bf16(v[0], v[1]); w.y = cvt_pk_bf16(v[2], v[3]); o[i] = w; } }
            } SEAM(P_PRO); }
        if (IN(P_G1)) { EpiFFN E{Hb, SS0}; run_gemm(lds, XB, WUP, NUP, D, E); if (REP_G1 > 1) run_gemm(lds, XB, WUP, NUP, D, E); SEAM(P_G1); }
        if (IN(P_G2)) { EpiResid E{args.in[I_X], X, XB, SS1, 0.5f}; run_gemm(lds, Hb, WDN, D, FF, E); if (REP_G2 > 1) run_gemm(lds, Hb, WDN, D, FF, E); SEAM(P_G2); }
        if (IN(P_G3A)) { EpiProj E; E.SS = SS1; E.lb = LB;
            E.seg[0] = Seg{Qb, D, 0, 1}; E.seg[1] = Seg{LFb, D, 4, 3}; E.seg[2] = Seg{Vb, D, 8, 0}; E.seg[3] = Seg{OGb, D, 12, 1}; E.nseg = 4;
            for (int rep = 0; rep < REP_G3A; ++rep) run_gemm(lds, XB, WIN, 4096, D, E); SEAM(P_G3A); }
        if (IN(P_HA)) { for (int rep = 0; rep < REP_HA; ++rep) for (int u = blockIdx.x; u < 1024; u += G) hgrn_a_unit(lds, u, LFb, Vb, Sb, DVEC, tid); SEAM(P_HA); }
        if (IN(P_SCAN)) { const int lane = FRESH_LANE();
            hgrn_scan(Sb, DVEC, gtid, nthr);
            LAS float* scr = (LAS float*)(lds + wave * 16384); int base = 0;
            transpose_up_job(args.in[I_F2W1], args.in[I_F2W3], WUP, args.in[I_F2N], scr, lane, gw, NGW, base);
            transpose_job(args.in[I_F2W2], FF, D, WDN, nullptr, scr, lane, gw, NGW, base);
            if (REP_TR > 1) { transpose_up_job(args.in[I_F2W1], args.in[I_F2W3], WUP, args.in[I_F2N], scr, lane, gw, NGW, base); transpose_job(args.in[I_F2W2], FF, D, WDN, nullptr, scr, lane, gw, NGW, base); }
            SEAM(P_SCAN); }
        if (IN(P_HC)) { for (int u = blockIdx.x; u < 1024; u += G) hgrn_c_unit(lds, u, Qb, LFb, Vb, OGb, Sb, args.in[I_ONORM], Qb, tid); SEAM(P_HC); }
        if (IN(P_G3B)) { EpiProj E; E.SS = SS1; E.lb = LB;
            E.seg[0] = Seg{Ub, POOLW, 0, 0}; E.seg[1] = Seg{LFb  , D, 2, 2}; E.seg[2] = Seg{Vb  , D, 6, 2}; E.seg[3] = E.seg[2]; E.nseg = 3;
            run_gemm(lds, XB, WIN + (size_t)4096 * D, 2560, D, E); if (REP_G3B > 1) run_gemm(lds, XB, WIN + (size_t)4096 * D, 2560, D, E); SEAM(P_G3B); }
        if (IN(P_POOL)) { for (int rep = 0; rep < REP_POOL; ++rep) {
            for (int it = gtid; it < M * 64; it += nthr) { const int row = it >> 6, c8 = it & 63, g = c8 >> 4, wdw = 2 << g, t = row & (SEQ - 1); const int cnt = (t + 1) < wdw ? (t + 1) : wdw;
                const bf16_t* up = Ub + (size_t)row * POOLW + c8 * 8; float s[8], u0[8];
#pragma unroll
                for (int e = 0; e < 8; ++e) s[e] = 0.f;
                for (int j = 0; j < cnt; ++j) { const u32x4 v = *(const u32x4*)(up - (size_t)j * POOLW); float f[8] = {__uint_as_float(v.x << 16), __uint_as_float(v.x & 0xffff0000u), __uint_as_float(v.y << 16), __uint_as_float(v.y & 0xffff0000u),
                        __uint_as_float(v.z << 16), __uint_as_float(v.z & 0xffff0000u), __uint_as_float(v.w << 16), __uint_as_float(v.w & 0xffff0000u)};
#pragma unroll
                    for (int e = 0; e < 8; ++e) { s[e] += f[e]; if (j == 0) u0[e] = f[e]; } }
                const float inv = 1.f / (float)cnt; u32x4 w;
                w.x = cvt_pk_bf16(s[0] * inv - u0[0], s[1] * inv - u0[1]); w.y = cvt_pk_bf16(s[2] * inv - u0[2], s[3] * inv - u0[3]); w.z = cvt_pk_bf16(s[4] * inv - u0[4], s[5] * inv - u0[5]); w.w = cvt_pk_bf16(s[6] * inv - u0[6], s[7] * inv - u0[7]);
                *(u32x4*)(POOLED + (size_t)row * POOLW + c8 * 8) = w; }
            } SEAM(P_POOL); }
        if (IN(P_G4A)) { EpiGate E{LFb, nullptr, YA}; run_gemm(lds, Qb, WA, D, D, E); }
        if (IN(P_G4B)) { EpiGate E{Vb, YA, YA}; run_gemm(lds, POOLED, WPB, D, POOLW, E); SEAM(P_G4B); }
        if (IN(P_G5)) { EpiResid E{X, X, XB, SS0, 1.0f}; run_gemm(lds, YA, WOUT, D, D, E); SEAM(P_G5); }
        if (IN(P_G6)) { EpiFFN E{Hb, SS0}; run_gemm(lds, XB, WUP, NUP, D, E); SEAM(P_G6); }
        if (IN(P_G7)) { EpiResid E{X, X, XB, SS1, 0.5f}; run_gemm(lds, Hb, WDN, D, FF, E); }
        if (IN(P_G8A)) { EpiEraw E{ERAW, SSE}; run_gemm(lds, PB, WPLE, D, PLE, E); SEAM(P_G8A); }
        if (IN(P_G8B)) { EpiPle E{X, ERAW, SS1, SSE, args.in[I_PLEPOST], SS0}; run_gemm(lds, XB, WG, D, D, E); SEAM(P_G8B); }
        if (IN(P_FIN)) { const int lane = FRESH_LANE();
            const float* gf = args.in[I_FINN];
            for (int m = gw; m < M; m += NGW) { float s = SS0[(size_t)m * 16 + (lane & 15)]; s += __shfl_xor(s, 1); s += __shfl_xor(s, 2); s += __shfl_xor(s, 4); s += __shfl_xor(s, 8);
                const float rs = rsqrtf(s * (1.0f / D) + EPS); f32x4* xr = (f32x4*)(X + (size_t)m * D) + lane; const f32x4* g4 = (const f32x4*)gf + lane;
#pragma unroll
                for (int j = 0; j < 4; ++j) { const f32x4 v = xr[64 * j]; xr[64 * j] = v * rs * g4[64 * j]; } }
        }
#undef IN
#undef SEAM
}

extern "C" void kernel_launch(void* const* d_in, const int* in_sizes, int n_in, void* d_out, int out_size, void* d_ws, size_t ws_size, hipStream_t stream) {
    static int grid = 0;
    if (grid == 0) {
        if (n_in != 24 || out_size != M * D || ws_size < WS_END) { fprintf(stderr, "kernel_launch: unexpected shapes (n_in %d out %d ws %zu)\n", n_in, out_size, ws_size); grid = -1; return; }
        int dev = 0, cus = 0, per_cu = 0;
        hipGetDevice(&dev); hipDeviceGetAttribute(&cus, hipDeviceAttributeMultiprocessorCount, dev);
        if (hipFuncSetAttribute((const void*)fwd_kernel, hipFuncAttributeMaxDynamicSharedMemorySize, LDS_BYTES) != hipSuccess) { fprintf(stderr, "kernel_launch: hipFuncSetAttribute failed\n"); grid = -1; return; }
        if (hipOccupancyMaxActiveBlocksPerMultiprocessor(&per_cu, (const void*)fwd_kernel, NTHR, LDS_BYTES) != hipSuccess || per_cu < 1) { fprintf(stderr, "kernel_launch: occupancy query failed (%d)\n", per_cu); (void)hipGetLastError(); per_cu = 1; }
        grid = cus * per_cu;
        fprintf(stderr, "kernel_launch: grid %d (cus %d x %d)\n", grid, cus, per_cu);
    }
    if (grid < 0) return;
    Args a{};
    for (int i = 0; i < 24; ++i) a.in[i] = (const float*)d_in[i];
    a.out = (float*)d_out; a.ws = (unsigned char*)d_ws;
#if MK_ONE_LAUNCH
    if (hipMemsetAsync((char*)d_ws + WS_CTL, 0, CTL_BYTES, stream) != hipSuccess) { fprintf(stderr, "kernel_launch: memset failed\n"); return; }
    a.ph_lo = 0; a.ph_hi = P_N;
    void* kargs[] = {&a};
    hipError_t e = hipLaunchCooperativeKernel((const void*)fwd_kernel, dim3(grid), dim3(NTHR), kargs, LDS_BYTES, stream);
    if (e != hipSuccess) fprintf(stderr, "kernel_launch: cooperative launch failed: %s (grid %d)\n", hipGetErrorString(e), grid);
#else
    for (int ph = 0; ph < P_N; ++ph) { a.ph_lo = ph; a.ph_hi = ph + 1; hipLaunchKernelGGL(fwd_kernel, dim3(grid), dim3(NTHR), LDS_BYTES, stream, a); }
#endif
}
```
